# Optimizing an MI355X kernel written in HIP

```python
import math
import jax, jax.numpy as jnp
from jax import lax
import numpy as np

D_MODEL = 1024
BATCH = 8
SEQ = 8192
DEPTH = 1
DEC_BATCH = 8
DEC_SEQ = 32
PAST_LEN = 4096

CHUNK = 64
Q_BLOCK = 128
ATTN_WIDTH = D_MODEL // 2
POOL_WIDTH = D_MODEL - ATTN_WIDTH
N_HEADS = 8
V_HEAD_DIM = ATTN_WIDTH // N_HEADS
QK_NOPE_DIM = 64
QK_ROPE_DIM = 32
Q_LORA_RANK = 256
KV_LORA_RANK = 128
ROPE_BASE = 10000.0
POOL_WINDOWS = (2, 4, 8, 16)
N_POOL_GROUPS = len(POOL_WINDOWS)
POOL_GROUP_DIM = POOL_WIDTH // N_POOL_GROUPS
POOL_STATE = max(POOL_WINDOWS) - 1
D_FF = -(-8 * D_MODEL // (3 * 256)) * 256
IN_WIDTH = Q_LORA_RANK + KV_LORA_RANK + QK_ROPE_DIM + POOL_WIDTH
SM_SCALE = 1.0 / math.sqrt(QK_NOPE_DIM + QK_ROPE_DIM)
EPS = 1e-6

kernel_name = "hymba_mla_pool_streaming_step"


def rmsnorm(x, g):
    xf = x.astype(jnp.float32)
    y = xf * lax.rsqrt(jnp.mean(xf * xf, axis=-1, keepdims=True) + EPS)
    return (y * g.astype(jnp.float32)).astype(x.dtype)


def rope(x, pos):
    d = x.shape[-1]
    freqs = jnp.power(ROPE_BASE, -jnp.arange(0, d, 2, dtype=jnp.float32) / d)
    ang = pos.astype(jnp.float32)[:, None] * freqs[None, :]
    cos = jnp.cos(ang)[None, :, None, :]
    sin = jnp.sin(ang)[None, :, None, :]
    xf = x.astype(jnp.float32)
    x1, x2 = xf[..., : d // 2], xf[..., d // 2:]
    return jnp.concatenate([x1 * cos - x2 * sin, x2 * cos + x1 * sin], axis=-1).astype(x.dtype)


def attend(q_lat, q_rope, keys_lat, keys_rope, q_pos, k_pos):
    s = (jnp.einsum('bqhr,bkr->bhqk', q_lat, keys_lat)
         + jnp.einsum('bqhd,bkd->bhqk', q_rope, keys_rope)).astype(jnp.float32) * SM_SCALE
    mask = (k_pos[None, :] // CHUNK) <= (q_pos[:, None] // CHUNK)
    s = jnp.where(mask[None, None], s, -jnp.inf)
    p = jax.nn.softmax(s, axis=-1).astype(keys_lat.dtype)
    return jnp.einsum('bhqk,bkr->bqhr', p, keys_lat)


def pool_mix(u, prev, w_pool, pool_scale, pos):
    B, T, _ = u.shape
    ext = jnp.concatenate([prev, u], axis=1)
    extf = ext.astype(jnp.float32)
    cs = jnp.concatenate([jnp.zeros((B, 1, POOL_WIDTH), jnp.float32),
                          jnp.cumsum(extf, axis=1)], axis=1)
    hi = cs[:, POOL_STATE + 1:]
    outs = []
    for g, w in enumerate(POOL_WINDOWS):
        sl = slice(g * POOL_GROUP_DIM, (g + 1) * POOL_GROUP_DIM)
        lo = cs[:, POOL_STATE + 1 - w: POOL_STATE + 1 - w + T, sl]
        cnt = jnp.minimum(pos + 1, w).astype(jnp.float32)[None, :, None]
        outs.append((hi[..., sl] - lo) / cnt - extf[:, POOL_STATE:, sl])
    pooled = jnp.stack(outs, axis=2).astype(u.dtype)
    mixed = jnp.einsum('btgc,gcd->btgd', pooled, w_pool).reshape(B, T, POOL_WIDTH)
    return mixed * pool_scale, ext[:, -POOL_STATE:]


def layer(x, pos, ckv_prev, kr_prev, pool_prev, g_norm1, w_in, g_q, w_uq, g_kv, w_uk, w_uv,
          w_pool, pool_scale, g_out_attn, g_out_pool, w_o, g_norm2, w_gate, w_up, w_down, blocked):
    B, T, _ = x.shape
    h = rmsnorm(x, g_norm1)
    z = h @ w_in
    a0 = Q_LORA_RANK
    a1 = a0 + KV_LORA_RANK
    a2 = a1 + QK_ROPE_DIM
    c_q, c_kv, k_r, u = z[..., :a0], z[..., a0:a1], z[..., a1:a2], z[..., a2:]
    q = (rmsnorm(c_q, g_q) @ w_uq).reshape(B, T, N_HEADS, QK_NOPE_DIM + QK_ROPE_DIM)
    q_nope, q_rope = q[..., :QK_NOPE_DIM], rope(q[..., QK_NOPE_DIM:], pos)
    q_lat = jnp.einsum('bthd,hrd->bthr', q_nope, w_uk)
    c_kv = rmsnorm(c_kv, g_kv)
    k_r = rope(k_r[:, :, None, :], pos)[:, :, 0, :]
    if ckv_prev is None:
        keys_lat, keys_rope, k_pos = c_kv, k_r, pos
    else:
        keys_lat = jnp.concatenate([ckv_prev, c_kv], axis=1)
        keys_rope = jnp.concatenate([kr_prev, k_r], axis=1)
        k_pos = jnp.concatenate([jnp.arange(ckv_prev.shape[1]), pos])
    if blocked:
        nb = T // Q_BLOCK
        ql_b = q_lat.reshape(B, nb, Q_BLOCK, N_HEADS, KV_LORA_RANK).transpose(1, 0, 2, 3, 4)
        qr_b = q_rope.reshape(B, nb, Q_BLOCK, N_HEADS, QK_ROPE_DIM).transpose(1, 0, 2, 3, 4)

        def blk(args):
            i, ql, qr = args
            qp = lax.dynamic_slice(pos, (i * Q_BLOCK,), (Q_BLOCK,))
            return attend(ql, qr, keys_lat, keys_rope, qp, k_pos)

        o_b = lax.map(blk, (jnp.arange(nb), ql_b, qr_b))
        o_lat = o_b.transpose(1, 0, 2, 3, 4).reshape(B, T, N_HEADS, KV_LORA_RANK)
    else:
        o_lat = attend(q_lat, q_rope, keys_lat, keys_rope, pos, k_pos)
    o_attn = jnp.einsum('bthr,hrd->bthd', o_lat, w_uv).reshape(B, T, ATTN_WIDTH)
    if pool_prev is None:
        pool_prev = jnp.zeros((B, POOL_STATE, POOL_WIDTH), u.dtype)
    o_pool, new_pool = pool_mix(u, pool_prev, w_pool, pool_scale, pos)
    mix = jnp.concatenate([rmsnorm(o_attn, g_out_attn), rmsnorm(o_pool, g_out_pool)], axis=-1) @ w_o
    x = x + mix
    h2 = rmsnorm(x, g_norm2)
    x = x + (jax.nn.silu(h2 @ w_gate) * (h2 @ w_up)) @ w_down
    return x, c_kv, k_r, new_pool


def setup_inputs(seed: int = 0) -> dict:
    key = jax.random.key(seed)
    ks = jax.random.split(key, 24)
    f32 = jnp.float32

    def nrm(k, shape, scale):
        return jax.random.normal(k, shape, f32) * scale

    def gain(k, shape):
        return 1.0 + 0.05 * jax.random.normal(k, shape, f32)

    L = DEPTH
    return {
        "x_prompt": nrm(ks[0], (BATCH, SEQ, D_MODEL), 1.0),
        "x_sample": nrm(ks[1], (DEC_BATCH, DEC_SEQ, D_MODEL), 1.0),
        "cache_kv_latent": nrm(ks[2], (L, DEC_BATCH, PAST_LEN, KV_LORA_RANK), 1.0),
        "cache_k_rope": nrm(ks[3], (L, DEC_BATCH, PAST_LEN, QK_ROPE_DIM), 1.0),
        "state_pool": nrm(ks[4], (L, DEC_BATCH, POOL_STATE, POOL_WIDTH), 1.0),
        "g_norm1": gain(ks[5], (L, D_MODEL)),
        "w_in": nrm(ks[6], (L, D_MODEL, IN_WIDTH), D_MODEL ** -0.5),
        "g_q": gain(ks[7], (L, Q_LORA_RANK)),
        "w_uq": nrm(ks[8], (L, Q_LORA_RANK, N_HEADS * (QK_NOPE_DIM + QK_ROPE_DIM)), Q_LORA_RANK ** -0.5),
        "g_kv": gain(ks[9], (L, KV_LORA_RANK)),
        "w_uk": nrm(ks[10], (L, N_HEADS, KV_LORA_RANK, QK_NOPE_DIM), KV_LORA_RANK ** -0.5),
        "w_uv": nrm(ks[11], (L, N_HEADS, KV_LORA_RANK, V_HEAD_DIM), KV_LORA_RANK ** -0.5),
        "w_pool": nrm(ks[12], (L, N_POOL_GROUPS, POOL_GROUP_DIM, POOL_GROUP_DIM), POOL_GROUP_DIM ** -0.5),
        "pool_scale": gain(ks[13], (L, POOL_WIDTH)),
        "g_out_attn": gain(ks[14], (L, ATTN_WIDTH)),
        "g_out_pool": gain(ks[15], (L, POOL_WIDTH)),
        "w_o": nrm(ks[16], (L, D_MODEL, D_MODEL), D_MODEL ** -0.5),
        "g_norm2": gain(ks[17], (L, D_MODEL)),
        "w_gate": nrm(ks[18], (L, D_MODEL, D_FF), D_MODEL ** -0.5),
        "w_up": nrm(ks[19], (L, D_MODEL, D_FF), D_MODEL ** -0.5),
        "w_down": nrm(ks[20], (L, D_FF, D_MODEL), D_FF ** -0.5),
        "g_final": gain(ks[21], (D_MODEL,)),
    }


def reference(x_prompt, x_sample, cache_kv_latent, cache_k_rope, state_pool,
              g_norm1, w_in, g_q, w_uq, g_kv, w_uk, w_uv, w_pool, pool_scale,
              g_out_attn, g_out_pool, w_o, g_norm2, w_gate, w_up, w_down, g_final):
    past = cache_kv_latent.shape[2]
    pos_p = jnp.arange(x_prompt.shape[1])
    pos_s = past + jnp.arange(x_sample.shape[1])
    xp, xs = x_prompt, x_sample
    ckv_p, kr_p, pool_p, ckv_s, kr_s, pool_s = [], [], [], [], [], []
    for l in range(DEPTH):
        w = (g_norm1[l], w_in[l], g_q[l], w_uq[l], g_kv[l], w_uk[l], w_uv[l], w_pool[l], pool_scale[l],
             g_out_attn[l], g_out_pool[l], w_o[l], g_norm2[l], w_gate[l], w_up[l], w_down[l])
        xp, a, b, c = layer(xp, pos_p, None, None, None, *w, blocked=True)
        ckv_p.append(a); kr_p.append(b); pool_p.append(c)
        xs, a, b, c = layer(xs, pos_s, cache_kv_latent[l], cache_k_rope[l], state_pool[l], *w, blocked=False)
        ckv_s.append(a); kr_s.append(b); pool_s.append(c)
    y_prompt = rmsnorm(xp, g_final)
    y_sample = rmsnorm(xs, g_final)
    return (y_prompt, y_sample,
            jnp.stack(ckv_p), jnp.stack(kr_p), jnp.stack(pool_p),
            jnp.stack(ckv_s), jnp.stack(kr_s), jnp.stack(pool_s))
```

```cpp
#include <hip/hip_runtime.h>
#include <hip/hip_cooperative_groups.h>
#include <cstdio>
#include <cstdint>
namespace cg = cooperative_groups;
namespace pg8 {
#define PG8_LAS __attribute__((address_space(3)))
typedef unsigned short bf16_t;
typedef short bf16x8 __attribute__((ext_vector_type(8)));
typedef float f32x4 __attribute__((ext_vector_type(4)));
typedef unsigned u32x4 __attribute__((ext_vector_type(4)));
constexpr int BM = 256, BK = 64, HALF = 128, HTB = HALF * BK * 2  , STAGE_BYTES = 8 * HTB, NXCD = 8, WGM = 8;

__host__ __device__ __forceinline__ int lds_byte(int r, int c) { const int st = (r >> 4) * 2 + (c >> 5), rr = r & 15, cc = c & 31, ob = rr * 64 + cc * 2; return st * 1024 + (ob ^ (((ob >> 9) & 1) << 5)); }
__host__ __device__ __forceinline__ void stage_rc(int b, int& R, int& C) { const int st = b / 1024, sb = b % 1024, swz = sb ^ (((sb >> 9) & 1) << 5); R = (st >> 1) * 16 + swz / 64; C = (st & 1) * 32 + (swz % 64) / 2; }
__host__ __device__ __forceinline__ int perm32(int rho) { const int n = rho >> 4, i = rho & 15; return 8 * (i >> 2) + 4 * n + (i & 3); }

struct Unit { int pm, pn; };
struct Gemm { const bf16_t* A; const bf16_t* Bt; int M, N, K; };

struct StaticOrder {
    int nM, nN, nwg, G, c, wgm;
    __host__ __device__ void init(int M, int N, int G_, int c_, int wgm_ = WGM) { nM = M / BM; nN = N / BM; nwg = nM * nN; G = G_; c = c_; wgm = wgm_; }
    __host__ __device__ bool next(int i, Unit& u) const {
        const long L = (long)i * G + c; if (L >= nwg) return false;
        int wgid = (int)L; { const int q = nwg / NXCD, r = nwg % NXCD, xcd = wgid % NXCD, off = wgid / NXCD; wgid = (xcd < r ? xcd * (q + 1) : r * (q + 1) + (xcd - r) * q) + off; }
        const int nig = wgm * nN, gid = wgid / nig, fm = gid * wgm, gsz = (nM - fm) < wgm ? (nM - fm) : wgm;
        u.pm = fm + ((wgid % nig) % gsz); u.pn = (wgid % nig) / gsz; return true;
    }
    __device__ __forceinline__ void a_ready(const Unit&) const {}
    __device__ __forceinline__ void done(const Unit&) const {}
};

__device__ __forceinline__ unsigned cvt_pk_bf16(float lo, float hi) { unsigned r; asm volatile("v_cvt_pk_bf16_f32 %0, %1, %2" : "=v"(r) : "v"(lo), "v"(hi)); return r; }
typedef float f32x2 __attribute__((ext_vector_type(2)));
typedef unsigned u32x2 __attribute__((ext_vector_type(2)));
struct EpiBf16 {
    static constexpr bool PERM = true, AFTER_DRAIN = false, MIDK = false;
    bf16_t* O; int ldc; float* ss;
    __device__ __forceinline__ void operator()(const f32x4 (&acc)[2][2][4][2], const Unit& u, int wr, int wc, int fr, int fq) const {
        int row0 = u.pm * BM + wr * 64 + fr; int col0 = u.pn * BM + wc * 32 + 8 * fq; asm volatile("" : "+v"(row0), "+v"(col0));
#pragma unroll
        for (int ai = 0; ai < 2; ++ai)
#pragma unroll
            for (int m = 0; m < 4; ++m) { bf16_t* rowp = O + (size_t)(row0 + ai * HALF + m * 16) * ldc + col0;
#pragma unroll
                for (int bj = 0; bj < 2; ++bj) { const f32x4 v0 = acc[ai][bj][m][0], v1 = acc[ai][bj][m][1];
                    u32x4 w; w.x = cvt_pk_bf16(v0[0], v0[1]); w.y = cvt_pk_bf16(v0[2], v0[3]); w.z = cvt_pk_bf16(v1[0], v1[1]); w.w = cvt_pk_bf16(v1[2], v1[3]);
                    *(u32x4*)(rowp + bj * HALF) = w; }
                if (ss) { float s = 0.f;
#pragma unroll
                    for (int bj = 0; bj < 2; ++bj)
#pragma unroll
                        for (int n = 0; n < 2; ++n) { const f32x4 v = acc[ai][bj][m][n]; s += (v[0] * v[0] + v[1] * v[1]) + (v[2] * v[2] + v[3] * v[3]); }
                    s += __shfl_xor(s, 16); s += __shfl_xor(s, 32);
                    if (fq == 0) ss[(size_t)(row0 + ai * HALF + m * 16) * 8 + u.pn * 4 + wc] = s; } }
    }
};
typedef _Float16 f16x2 __attribute__((ext_vector_type(2)));
struct EpiQRope {
    static constexpr bool PERM = true, AFTER_DRAIN = false, MIDK = false;
    bf16_t* O; const unsigned* tab16; float scale;
    __device__ __forceinline__ void operator()(const f32x4 (&acc)[2][2][4][2], const Unit& u, int wr, int wc, int fr, int fq) const {
        int row0 = u.pm * BM + wr * 64 + fr; int col0 = u.pn * BM + wc * 32 + 8 * fq; asm volatile("" : "+v"(row0), "+v"(col0));
#pragma unroll
        for (int bj = 0; bj < 2; ++bj) {
            const int c = col0 + bj * HALF; const int cm = c % 160; const bool rope = cm >= 128; const int ip = rope ? ((cm - 128) >> 1) : 0;
            u32x4 tw[8];
#pragma unroll
            for (int it = 0; it < 8; ++it) { const int row = row0 + (it >> 2) * HALF + (it & 3) * 16; const int pos = row < 65536 ? (row & 8191) : 4096 + ((row - 65536) & 31);
                tw[it] = *(const u32x4*)(tab16 + (size_t)pos * 16 + ip); }
#pragma unroll
            for (int it = 0; it < 8; ++it) {
                const int ai = it >> 2, m = it & 3;
                const int row = row0 + ai * HALF + m * 16;
                f32x4 v0 = acc[ai][bj][m][0], v1 = acc[ai][bj][m][1];
                float cs[4], sn[4];
#pragma unroll
                for (int k = 0; k < 4; ++k) { const unsigned wk = tw[it][k]; const f16x2 hv = __builtin_bit_cast(f16x2, wk);        cs[k] = rope ? (float)hv[0] : 1.0f; sn[k] = rope ? (float)hv[1] : 0.0f; }
                float a, b;
                a = v0[0]; b = v0[1]; v0[0] = a * cs[0] - b * sn[0]; v0[1] = b * cs[0] + a * sn[0];
                a = v0[2]; b = v0[3]; v0[2] = a * cs[1] - b * sn[1]; v0[3] = b * cs[1] + a * sn[1];
                a = v1[0]; b = v1[1]; v1[0] = a * cs[2] - b * sn[2]; v1[1] = b * cs[2] + a * sn[2];
                a = v1[2]; b = v1[3]; v1[2] = a * cs[3] - b * sn[3]; v1[3] = b * cs[3] + a * sn[3];
                v0 = v0 * scale; v1 = v1 * scale;
                u32x4 w; w.x = cvt_pk_bf16(v0[0], v0[1]); w.y = cvt_pk_bf16(v0[2], v0[3]); w.z = cvt_pk_bf16(v1[0], v1[1]); w.w = cvt_pk_bf16(v1[2], v1[3]);
                *(u32x4*)(O + (size_t)row * 1280 + c) = w;
            }
        }
    }
};
template <bool WO> struct EpiRes {
    static constexpr bool PERM = false, AFTER_DRAIN = false, MIDK = WO;
    const float* xp; const float* xs; float* out; bf16_t* xb; float* ss; const float* ratio; const float* rp;
    __device__ __forceinline__ void midk(f32x4 (&acc)[2][2][4][2], const Unit& u, int wr, int wc, int fr, int fq) const {
        int rowg = u.pm * BM + wr * 64 + fr; asm volatile("" : "+v"(rowg));
#pragma unroll
        for (int ai = 0; ai < 2; ++ai)
#pragma unroll
            for (int m = 0; m < 4; ++m) { const float rt = ratio[rowg + ai * HALF + m * 16];
#pragma unroll
                for (int bj = 0; bj < 2; ++bj)
#pragma unroll
                    for (int n = 0; n < 2; ++n) acc[ai][bj][m][n] = acc[ai][bj][m][n] * rt; }
    }
    __device__ __forceinline__ void operator()(const f32x4 (&acc)[2][2][4][2], const Unit& u, int wr, int wc, int fr, int fq) const {
        int rowl = wr * 64 + fr; int col0 = u.pn * BM + wc * 32 + 4 * fq; asm volatile("" : "+v"(rowl), "+v"(col0));
        float* dst = out + (size_t)u.pm * BM * 1024;
        const float* src = WO ? (u.pm < 256 ? xp + (size_t)u.pm * BM * 1024 : xs) : (const float*)dst;
        f32x4 cx[2][2]; float crp = 1.0f;
#pragma unroll
        for (int bj = 0; bj < 2; ++bj)
#pragma unroll
            for (int n = 0; n < 2; ++n) { const f32x4* sp_ = (const f32x4*)(src + (size_t)rowl * 1024 + col0 + bj * HALF + n * 16); cx[bj][n] = WO ? __builtin_nontemporal_load(sp_) : *sp_; }
        if (WO) crp = rp[(size_t)u.pm * BM + rowl];
#pragma unroll
        for (int it = 0; it < 8; ++it) {
            const int ai = it >> 2, m = it & 3;
            const int r = rowl + ai * HALF + m * 16; float s = 0.f;
            f32x4 nx[2][2]; float nrp = 1.0f;
            if (it < 7) { const int rn = rowl + ((it + 1) >> 2) * HALF + ((it + 1) & 3) * 16;
#pragma unroll
                for (int bj = 0; bj < 2; ++bj)
#pragma unroll
                    for (int n = 0; n < 2; ++n) { const f32x4* sp_ = (const f32x4*)(src + (size_t)rn * 1024 + col0 + bj * HALF + n * 16); nx[bj][n] = WO ? __builtin_nontemporal_load(sp_) : *sp_; }
                if (WO) nrp = rp[(size_t)u.pm * BM + rn]; }
#pragma unroll
            for (int bj = 0; bj < 2; ++bj)
#pragma unroll
                for (int n = 0; n < 2; ++n) {
                    const int c = col0 + bj * HALF + n * 16;
                    const f32x4 v = cx[bj][n] + (WO ? acc[ai][bj][m][n] * crp : acc[ai][bj][m][n]);
                    if (WO) __builtin_nontemporal_store(v, (f32x4*)(dst + (size_t)r * 1024 + c)); else *(f32x4*)(dst + (size_t)r * 1024 + c) = v;
                    s += (v[0] * v[0] + v[1] * v[1]) + (v[2] * v[2] + v[3] * v[3]);
                    if (WO) { u32x2 w; w.x = cvt_pk_bf16(v[0], v[1]); w.y = cvt_pk_bf16(v[2], v[3]); *(u32x2*)(xb + ((size_t)u.pm * BM + r) * 1024 + c) = w; }
                }
            if (WO) { s += __shfl_xor(s, 16); s += __shfl_xor(s, 32);
                if (fq == 0) ss[((size_t)u.pm * BM + r) * 16 + u.pn * 4 + wc] = s; }
            asm volatile("" ::: "memory");
            if (it < 7) {
#pragma unroll
                for (int bj = 0; bj < 2; ++bj)
#pragma unroll
                    for (int n = 0; n < 2; ++n) cx[bj][n] = nx[bj][n];
                crp = nrp; }
        }
    }
};
struct EpiGateUp {
    static constexpr bool PERM = true, AFTER_DRAIN = false, MIDK = false;
    bf16_t* H; const float* ss;
    __device__ __forceinline__ void operator()(const f32x4 (&acc)[2][2][4][2], const Unit& u, int wr, int wc, int fr, int fq) const {
        int row0 = u.pm * BM + wr * 64 + fr; int hc0 = u.pn * HALF + wc * 32 + 8 * fq; asm volatile("" : "+v"(row0), "+v"(hc0));
        f32x4 sl[8];
#pragma unroll
        for (int it = 0; it < 8; ++it) sl[it] = *(const f32x4*)(ss + (size_t)(row0 + (it >> 2) * HALF + (it & 3) * 16) * 16 + 4 * fq);
        float rr[8];
#pragma unroll
        for (int it = 0; it < 8; ++it) { float s = (sl[it][0] + sl[it][1]) + (sl[it][2] + sl[it][3]); s += __shfl_xor(s, 16); s += __shfl_xor(s, 32);
            rr[it] = __builtin_amdgcn_rsqf(s * (1.0f / 1024.0f) + 1e-6f); }
#pragma unroll
        for (int ai = 0; ai < 2; ++ai)
#pragma unroll
            for (int m = 0; m < 4; ++m) {
                const int row = row0 + ai * HALF + m * 16;
                const float r = rr[ai * 4 + m];
                f32x4 hv[2];
#pragma unroll
                for (int n = 0; n < 2; ++n) {
                    const f32x4 g = acc[ai][0][m][n] * r, up = acc[ai][1][m][n] * r;
#pragma unroll
                    for (int e2 = 0; e2 < 4; ++e2) { const float sg = __builtin_amdgcn_rcpf(1.0f + __builtin_amdgcn_exp2f(-1.4426950408889634f * g[e2])); hv[n][e2] = g[e2] * sg * up[e2]; }
                }
                u32x4 w; w.x = cvt_pk_bf16(hv[0][0], hv[0][1]); w.y = cvt_pk_bf16(hv[0][2], hv[0][3]); w.z = cvt_pk_bf16(hv[1][0], hv[1][1]); w.w = cvt_pk_bf16(hv[1][2], hv[1][3]);
                __builtin_nontemporal_store(w, (u32x4*)(H + (size_t)row * 2816 + hc0));
            }
    }
};
struct EpiDownNorm {
    static constexpr bool PERM = false, AFTER_DRAIN = false, MIDK = false;
    float* out; const float* g; float* xs; unsigned* cnt; unsigned* tmo; PG8_LAS unsigned char* sl;
    __device__ __forceinline__ void operator()(f32x4 (&acc)[2][2][4][2], const Unit& u, int wr, int wc, int fr, int fq) const {
        int rowl = wr * 64 + fr; int col0 = u.pn * BM + wc * 32 + 4 * fq; asm volatile("" : "+v"(rowl), "+v"(col0));
        float* dst = out + (size_t)u.pm * BM * 1024;
        PG8_LAS float* Pt = (PG8_LAS float*)sl;
        PG8_LAS float* St = (PG8_LAS float*)(sl + 4096);
        PG8_LAS unsigned* flag = (PG8_LAS unsigned*)(sl + 5120);
        const int tid = threadIdx.x, lane = tid & 63, wid = tid >> 6;
#pragma unroll
        for (int ai = 0; ai < 2; ++ai)
#pragma unroll
            for (int m = 0; m < 4; ++m) {
                const int r = rowl + ai * HALF + m * 16; float s = 0.f;
#pragma unroll
                for (int bj = 0; bj < 2; ++bj)
#pragma unroll
                    for (int n = 0; n < 2; ++n) { const f32x4 v = *(const f32x4*)(dst + (size_t)r * 1024 + col0 + bj * HALF + n * 16) + acc[ai][bj][m][n]; acc[ai][bj][m][n] = v;
                        s += (v[0] * v[0] + v[1] * v[1]) + (v[2] * v[2] + v[3] * v[3]); }
                s += __shfl_xor(s, 16); s += __shfl_xor(s, 32);
                if (fq == 0) Pt[r * 4 + wc] = s;
                if (m & 1) asm volatile("" ::: "memory");
            }
        asm volatile("s_waitcnt lgkmcnt(0)\n\ts_barrier" ::: "memory");
        if (tid < 256) {
            const f32x4 p = *(const PG8_LAS f32x4*)(Pt + tid * 4);
            __hip_atomic_store(xs + ((size_t)u.pm * BM + tid) * 4 + u.pn, (p[0] + p[1]) + (p[2] + p[3]), __ATOMIC_RELAXED, __HIP_MEMORY_SCOPE_AGENT);
            asm volatile("s_waitcnt vmcnt(0)" ::: "memory");
            if (lane == 0) __hip_atomic_fetch_add(cnt + 64 * u.pm, 1u, __ATOMIC_RELAXED, __HIP_MEMORY_SCOPE_AGENT);
        }
        if (wid == 0) {
            unsigned sp = 0; bool dead = false;
            while ((unsigned)__builtin_amdgcn_readfirstlane(__hip_atomic_load(cnt + 64 * u.pm, __ATOMIC_RELAXED, __HIP_MEMORY_SCOPE_AGENT)) < 16u) {
                __builtin_amdgcn_s_sleep(2);
                if (++sp > (1u << 22)) { dead = true; break; }
            }
            __builtin_amdgcn_fence(__ATOMIC_ACQUIRE, "agent");
            if (lane == 0) { flag[0] = dead ? 1u : 0u; if (dead) __hip_atomic_store(tmo, 1u, __ATOMIC_RELAXED, __HIP_MEMORY_SCOPE_AGENT); }
        }
        asm volatile("s_waitcnt vmcnt(0) lgkmcnt(0)\n\ts_barrier" ::: "memory");
        if (tid < 256) {
            const float* sp4 = xs + ((size_t)u.pm * BM + tid) * 4; float t = 0.f;
#pragma unroll
            for (int k = 0; k < 4; ++k) t += __hip_atomic_load(sp4 + k, __ATOMIC_RELAXED, __HIP_MEMORY_SCOPE_AGENT);
            St[tid] = __builtin_amdgcn_rsqf(t * (1.0f / 1024.0f) + 1e-6f);
        }
        asm volatile("s_waitcnt lgkmcnt(0)\n\ts_barrier" ::: "memory");
        f32x4 gv[2][2];
#pragma unroll
        for (int bj = 0; bj < 2; ++bj)
#pragma unroll
            for (int n = 0; n < 2; ++n) gv[bj][n] = *(const f32x4*)(g + col0 + bj * HALF + n * 16);
#pragma unroll
        for (int ai = 0; ai < 2; ++ai)
#pragma unroll
            for (int m = 0; m < 4; ++m) {
                const int r = rowl + ai * HALF + m * 16; const float rs = St[r];
#pragma unroll
                for (int bj = 0; bj < 2; ++bj)
#pragma unroll
                    for (int n = 0; n < 2; ++n) __builtin_nontemporal_store(acc[ai][bj][m][n] * rs * gv[bj][n], (f32x4*)(dst + (size_t)r * 1024 + col0 + bj * HALF + n * 16));
            }
        asm volatile("s_waitcnt lgkmcnt(0)\n\ts_barrier" ::: "memory");
    }
};
template <class Epi, class Sched, bool ALIGN_EPI = false, bool SP2 = false>
__device__ __forceinline__ void gemm_phase(PG8_LAS unsigned char* lds, const Gemm g, const Sched& S, const Epi& E) {
    int tid_l = threadIdx.x; asm volatile("" : "+v"(tid_l)); const int tid = tid_l, wid = __builtin_amdgcn_readfirstlane(tid >> 6), lane = tid & 63, wr = wid >> 2, wc = wid & 3, fr = lane & 15, fq = lane >> 4;
    int K_l = g.K; asm volatile("" : "+s"(K_l)); const int K = K_l, nt = K / BK;
    unsigned voffA[2], voffB[2];
#pragma unroll
    for (int i = 0; i < 2; ++i) { int R, C; stage_rc(tid * 16 + i * 8192, R, C); const int Rb = Epi::PERM ? ((R & ~31) + perm32(R & 31)) : R;
        voffA[i] = (unsigned)(R * K + C) * 2u; voffB[i] = (unsigned)(Rb * K + C) * 2u; }
    const size_t kstep = (size_t)(BK * 2);
    const size_t hstep = (size_t)HALF * K * 2;
    const size_t tstep = 2 * hstep;
    const unsigned ldsw = (unsigned)wid * 1024u;
    const int aoff = lds_byte(wr * 64 + fr, fq * 8), boff = lds_byte(wc * 32 + fr, fq * 8);
#define PG8_SA(b, h) (((b) * 2 + (h)) * HTB)
#define PG8_SB(b, h) ((4 + (b) * 2 + (h)) * HTB)
#define PG8_STAGE(bufoff, gbase, voff) do { _Pragma("unroll") for (int _i = 0; _i < 2; ++_i) \
        __builtin_amdgcn_global_load_lds((const unsigned*)((const char*)(gbase) + (voff)[_i]), (PG8_LAS unsigned*)(lds + (bufoff) + ldsw + _i * 8192), 16, 0, 0); } while (0)
#define PG8_LDA(dst, b, h) do { _Pragma("unroll") for (int m = 0; m < 4; ++m) _Pragma("unroll") for (int k = 0; k < 2; ++k) dst[m][k] = *(const PG8_LAS bf16x8*)(lds + PG8_SA(b, h) + aoff + m * 2048 + k * 1024); } while (0)
#define PG8_LDB(dst, b, h) do { _Pragma("unroll") for (int n = 0; n < 2; ++n) _Pragma("unroll") for (int k = 0; k < 2; ++k) dst[n][k] = *(const PG8_LAS bf16x8*)(lds + PG8_SB(b, h) + boff + n * 2048 + k * 1024); } while (0)
#define PG8_MMA(ai, bj, At, Bt) do { __builtin_amdgcn_s_setprio(1); _Pragma("unroll") for (int m = 0; m < 4; ++m) _Pragma("unroll") for (int n = 0; n < 2; ++n) _Pragma("unroll") for (int k = 0; k < 2; ++k) \
        acc[ai][bj][m][n] = __builtin_amdgcn_mfma_f32_16x16x32_bf16(Bt[n][k], At[m][k], acc[ai][bj][m][n], 0, 0, 0); __builtin_amdgcn_s_setprio(0); } while (0)
#define PG8_WAIT_V(n) asm volatile("s_waitcnt vmcnt(" #n ")" ::: "memory")
#define PG8_WAIT_L(n) asm volatile("s_waitcnt lgkmcnt(" #n ")" ::: "memory")
#define PG8_BAR __builtin_amdgcn_s_barrier()
#define PG8_SCHED __builtin_amdgcn_sched_barrier(0)
    Unit cur, nxt; int ui = 0;
    if (!S.next(0, cur)) return;
    f32x4 acc[2][2][4][2];
#pragma unroll
    for (int a = 0; a < 2; ++a)
#pragma unroll
        for (int b = 0; b < 2; ++b)
#pragma unroll
            for (int m = 0; m < 4; ++m)
#pragma unroll
                for (int n = 0; n < 2; ++n) acc[a][b][m][n] = (f32x4){0.f, 0.f, 0.f, 0.f};
    bf16x8 At[4][2], B0[2][2], B1[2][2];
    const char* cA = (const char*)g.A + (size_t)cur.pm * tstep; const char* cB = (const char*)g.Bt + (size_t)cur.pn * tstep;
    S.a_ready(cur);
    if constexpr (SP2) {
        PG8_STAGE(PG8_SB(0, 0), cB, voffB); PG8_STAGE(PG8_SB(0, 1), cB + hstep, voffB); PG8_STAGE(PG8_SA(0, 0), cA, voffA); PG8_STAGE(PG8_SA(0, 1), cA + hstep, voffA);
        if (wr == 1) PG8_BAR;
        PG8_WAIT_V(2); PG8_BAR;
        PG8_STAGE(PG8_SB(1, 0), cB + kstep, voffB); PG8_STAGE(PG8_SA(1, 0), cA + kstep, voffA); PG8_STAGE(PG8_SB(1, 1), cB + hstep + kstep, voffB);
        PG8_WAIT_V(6); PG8_BAR;
    } else {
        PG8_STAGE(PG8_SB(0, 0), cB, voffB); PG8_STAGE(PG8_SA(0, 0), cA, voffA); PG8_STAGE(PG8_SB(0, 1), cB + hstep, voffB); PG8_STAGE(PG8_SA(0, 1), cA + hstep, voffA);
        if (wr == 1) PG8_BAR;
        PG8_WAIT_V(4); PG8_BAR;
        PG8_STAGE(PG8_SB(1, 0), cB + kstep, voffB); PG8_STAGE(PG8_SA(1, 0), cA + kstep, voffA); PG8_STAGE(PG8_SB(1, 1), cB + hstep + kstep, voffB);
        PG8_WAIT_V(6); PG8_BAR;
    }
    for (;;) {
        const bool has_next = S.next(ui + 1, nxt);
        const char* nA = has_next ? (const char*)g.A + (size_t)nxt.pm * tstep : cA; const char* nB = has_next ? (const char*)g.Bt + (size_t)nxt.pn * tstep : cB;
        for (int t = 0; t < nt; t += 2) {
            const bool last = (t == nt - 2);
            const char* a1 = cA + (size_t)(t + 1) * kstep;
            const char* a2 = last ? nA : cA + (size_t)(t + 2) * kstep; const char* b2 = last ? nB : cB + (size_t)(t + 2) * kstep;
            const char* a3 = a2 + kstep; const char* b3 = b2 + kstep;
            if (last && has_next) S.a_ready(nxt);
            if constexpr (Epi::MIDK) { if (t == nt / 2) E.midk(acc, cur, wr, wc, fr, fq); }
            if constexpr (SP2) {
            PG8_LDB(B0, 0, 0); PG8_LDB(B1, 0, 1); PG8_SCHED; PG8_LDA(At, 0, 0); PG8_STAGE(PG8_SA(1, 1), a1 + hstep, voffA);
            PG8_WAIT_V(8); PG8_WAIT_L(0); PG8_BAR; PG8_MMA(0, 0, At, B0); PG8_MMA(0, 1, At, B1); PG8_BAR; PG8_SCHED;
            PG8_LDA(At, 0, 1); PG8_STAGE(PG8_SB(0, 0), b2, voffB); PG8_STAGE(PG8_SB(0, 1), b2 + hstep, voffB); PG8_STAGE(PG8_SA(0, 0), a2, voffA);
            PG8_WAIT_V(8); PG8_WAIT_L(0); PG8_BAR; PG8_MMA(1, 0, At, B0); PG8_MMA(1, 1, At, B1); PG8_BAR; PG8_SCHED;
            PG8_LDB(B0, 1, 0); PG8_LDB(B1, 1, 1); PG8_SCHED; PG8_LDA(At, 1, 0); PG8_STAGE(PG8_SA(0, 1), a2 + hstep, voffA);
            PG8_WAIT_V(8); PG8_WAIT_L(0); PG8_BAR; PG8_MMA(0, 0, At, B0); PG8_MMA(0, 1, At, B1); PG8_BAR; PG8_SCHED;
            PG8_LDA(At, 1, 1); PG8_STAGE(PG8_SB(1, 0), b3, voffB); PG8_STAGE(PG8_SB(1, 1), b3 + hstep, voffB); PG8_STAGE(PG8_SA(1, 0), a3, voffA);
            PG8_WAIT_V(8); PG8_WAIT_L(0); PG8_BAR; PG8_MMA(1, 0, At, B0); PG8_MMA(1, 1, At, B1); PG8_BAR; PG8_SCHED;
            } else {
            PG8_LDB(B0, 0, 0); PG8_SCHED; PG8_LDA(At, 0, 0); PG8_STAGE(PG8_SA(1, 1), a1 + hstep, voffA);
            PG8_WAIT_L(8); PG8_BAR; PG8_WAIT_L(0); PG8_MMA(0, 0, At, B0); PG8_BAR; PG8_SCHED;
            PG8_LDB(B1, 0, 1); PG8_STAGE(PG8_SB(0, 0), b2, voffB);
            PG8_BAR; PG8_WAIT_L(0); PG8_MMA(0, 1, At, B1); PG8_BAR;
            PG8_LDA(At, 0, 1); PG8_STAGE(PG8_SA(0, 0), a2, voffA);
            PG8_BAR; PG8_WAIT_L(0); PG8_MMA(1, 0, At, B0); PG8_BAR; PG8_SCHED;
            PG8_STAGE(PG8_SB(0, 1), b2 + hstep, voffB);
            PG8_WAIT_V(6); PG8_BAR; PG8_MMA(1, 1, At, B1); PG8_BAR;
            PG8_LDB(B0, 1, 0); PG8_SCHED; PG8_LDA(At, 1, 0); PG8_STAGE(PG8_SA(0, 1), a2 + hstep, voffA);
            PG8_WAIT_L(8); PG8_BAR; PG8_WAIT_L(0); PG8_MMA(0, 0, At, B0); PG8_BAR; PG8_SCHED;
            PG8_LDB(B1, 1, 1); PG8_STAGE(PG8_SB(1, 0), b3, voffB);
            PG8_BAR; PG8_WAIT_L(0); PG8_MMA(0, 1, At, B1); PG8_BAR;
            PG8_LDA(At, 1, 1); PG8_STAGE(PG8_SA(1, 0), a3, voffA);
            PG8_BAR; PG8_WAIT_L(0); PG8_MMA(1, 0, At, B0); PG8_BAR; PG8_SCHED;
            PG8_STAGE(PG8_SB(1, 1), b3 + hstep, voffB);
            PG8_WAIT_V(6); PG8_BAR; PG8_MMA(1, 1, At, B1); PG8_BAR;
            }
        }
        if constexpr (ALIGN_EPI) { if (wr == 0) PG8_BAR; }
        if constexpr (!Epi::AFTER_DRAIN) { E(acc, cur, wr, wc, fr, fq); S.done(cur); }
        if (!has_next) break;
#pragma unroll
        for (int a = 0; a < 2; ++a)
#pragma unroll
            for (int b = 0; b < 2; ++b)
#pragma unroll
                for (int m = 0; m < 4; ++m)
#pragma unroll
                    for (int n = 0; n < 2; ++n) acc[a][b][m][n] = (f32x4){0.f, 0.f, 0.f, 0.f};
        cur = nxt; cA = nA; cB = nB; ++ui;
        if constexpr (ALIGN_EPI) { if (wr == 1) PG8_BAR; }
    }
    PG8_WAIT_V(0);
    if constexpr (!ALIGN_EPI) { if (wr == 0) PG8_BAR; }
    PG8_BAR;
    if constexpr (Epi::AFTER_DRAIN) { E.fused(acc, cur, wr, wc, fr, fq, lds, wid, lane); S.done(cur); }
#undef PG8_SA
#undef PG8_SB
#undef PG8_STAGE
#undef PG8_LDA
#undef PG8_LDB
#undef PG8_MMA
#undef PG8_WAIT_V
#undef PG8_WAIT_L
#undef PG8_BAR
#undef PG8_SCHED
}
}
#define LAS __attribute__((address_space(3)))
typedef unsigned short bf16;
typedef unsigned u32x4 __attribute__((ext_vector_type(4)));
typedef unsigned u32x2 __attribute__((ext_vector_type(2)));
typedef float f32x4 __attribute__((ext_vector_type(4)));
typedef float f32x16 __attribute__((ext_vector_type(16)));
typedef short bf16x8 __attribute__((ext_vector_type(8)));
typedef short s16x4 __attribute__((ext_vector_type(4)));
typedef short v4i16_t __attribute__((ext_vector_type(4)));

constexpr int NTOK_P = 65536, NTOK_S = 256, NT = NTOK_P + NTOK_S;
constexpr int DM = 1024, DFF = 2816, INW = 928;
constexpr float EPS = 1e-6f;
constexpr float QSCALE = 0.10206207261596575f * 1.4426950408889634f;
constexpr int SKV = 4160;

constexpr size_t MiB = 1u << 20;
constexpr size_t WS_CTL = 0, WS_TAB = 1 * MiB, WS_WIN = 2 * MiB, WS_WO = 4 * MiB, WS_WQ = 6 * MiB, WS_WUV = 7 * MiB, WS_WPOOL = 8 * MiB, WS_TAB16 = 8 * MiB + 512 * 1024, WS_WD = 9 * MiB, WS_WGU = 15 * MiB;
constexpr size_t WS_SS2 = 26 * MiB, WS_SSP = 31 * MiB, WS_XS = 26 * MiB, WS_RP = 34 * MiB, WS_RATIO = 35 * MiB;
constexpr size_t WS_A = 36 * MiB;
constexpr size_t WS_B = 165 * MiB;
constexpr size_t WS_CQ = 294 * MiB, WS_KLP = 327 * MiB, WS_KLS = 348 * MiB, WS_VTP = 359 * MiB, WS_VTS = 377 * MiB, WS_POOLED = 387 * MiB, WS_QL = 452 * MiB;
constexpr size_t WS_H = 165 * MiB;
constexpr size_t WS_END = 613 * MiB;
static_assert(WS_KLP + (size_t)NTOK_P * 336 <= WS_KLS && WS_KLS + (size_t)8 * SKV * 336 <= WS_VTP && WS_VTP + (size_t)1024 * 18432 <= WS_VTS && WS_VTS + (size_t)8 * 65 * 18432 <= WS_POOLED && WS_POOLED + (size_t)NT * 1024 <= WS_QL, "ws map");
static_assert(WS_H + (size_t)NT * DFF * 2 <= WS_END, "H overlay");
static_assert(WS_QL + (size_t)NT * 1280 * 2 <= WS_END, "QL");

constexpr size_t O_Y = 0, O_KVP = (size_t)NT * DM, O_KRP = O_KVP + (size_t)NTOK_P * 128, O_POOLP = O_KRP + (size_t)NTOK_P * 32, O_KVS = O_POOLP + 8 * 15 * 512,
                 O_KRS = O_KVS + (size_t)NTOK_S * 128, O_POOLS = O_KRS + (size_t)NTOK_S * 32, O_END = O_POOLS + 8 * 15 * 512;

constexpr int LDS_BYTES = 131072 + 2048 + 6144;
constexpr int NTHREADS = 512;
#ifndef P8_ALIGN
#define P8_ALIGN true
#endif
#ifndef P8_SP2
#define P8_SP2 true
#endif
#ifndef P8_WGM
#define P8_WGM 8
#endif

#define LDS_WAIT() asm volatile("s_waitcnt lgkmcnt(0)" ::: "memory")
typedef float f32x2_t __attribute__((ext_vector_type(2))); typedef __bf16 bf16x2_t __attribute__((ext_vector_type(2)));
__device__ __forceinline__ unsigned pk2(float lo, float hi) { return pg8::cvt_pk_bf16(lo, hi); }
__device__ __forceinline__ unsigned pk2v(float lo, float hi) { f32x2_t v = {lo, hi}; bf16x2_t b = __builtin_convertvector(v, bf16x2_t); return __builtin_bit_cast(unsigned, b); }
__device__ __forceinline__ float bflo(unsigned u) { return __builtin_bit_cast(float, u << 16); }
__device__ __forceinline__ float bfhi(unsigned u) { return __builtin_bit_cast(float, u & 0xffff0000u); }
__device__ __forceinline__ float wave_sum(float v) {
#pragma unroll
    for (int o = 1; o < 64; o <<= 1) v += __shfl_xor(v, o);
    return v;
}

struct Params { const float* in[22]; float* out; unsigned char* ws; };
enum { I_XP = 0, I_XS, I_CKV, I_CKR, I_SPOOL, I_GN1, I_WIN, I_GQ, I_WUQ, I_GKV, I_WUK, I_WUV, I_WPOOL, I_PSCALE, I_GOA, I_GOP, I_WO, I_GN2, I_WG, I_WU, I_WD, I_GF };

template <bool KPERM = false>
__device__ __forceinline__ void tr_item(const float* W, int ldw, const float* kscale, const float* nscale, bf16* WT, int ldt, int drow0, int dcol0, LAS float* scr, int lane) {
    f32x4 wv[8];
#pragma unroll
    for (int i = 0; i < 8; ++i) wv[i] = *(const f32x4*)(W + (size_t)(8 * i + (lane >> 3)) * ldw + 4 * (lane & 7));
    f32x4 nsc = {1.f, 1.f, 1.f, 1.f}; if (nscale) nsc = *(const f32x4*)(nscale + 4 * (lane & 7));
#pragma unroll
    for (int i = 0; i < 8; ++i) { const int kk = 8 * i + (lane >> 3); f32x4 v = wv[i] * nsc; if (kscale) v = v * kscale[kk];
        LAS float* d = scr + kk * 33 + 4 * (lane & 7); d[0] = v[0]; d[1] = v[1]; d[2] = v[2]; d[3] = v[3]; }
    LDS_WAIT(); asm volatile("" ::: "memory");
    const int c = lane & 7;
#pragma unroll
    for (int j = 0; j < 4; ++j) { const int n = (lane >> 3) + 8 * j; const LAS float* s = scr + (KPERM ? ((8 * c) & ~15) + 4 * (c & 1) : 8 * c) * 33 + n; constexpr int HS = KPERM ? 8 : 4;
        u32x4 o; o.x = pk2(s[0 * 33], s[1 * 33]); o.y = pk2(s[2 * 33], s[3 * 33]); o.z = pk2(s[HS * 33], s[(HS + 1) * 33]); o.w = pk2(s[(HS + 2) * 33], s[(HS + 3) * 33]);
        *(u32x4*)(WT + (size_t)(drow0 + n) * ldt + dcol0 + 8 * c) = o; }
    LDS_WAIT(); asm volatile("" ::: "memory");
}

__device__ __forceinline__ void p0_prologue(const Params& P, LAS unsigned char* lds) {
    int tid_l = threadIdx.x; asm volatile("" : "+v"(tid_l)); const int tid = tid_l, lane = tid & 63, wave = tid >> 6;
    unsigned char* ws = P.ws;
    LAS float* scr = (LAS float*)(lds + wave * 16384);
    const int gw = blockIdx.x * 8 + wave, NGW = gridDim.x * 8;
    const int gt = blockIdx.x * NTHREADS + tid, GT = gridDim.x * NTHREADS;
    bf16* WinT = (bf16*)(ws + WS_WIN); bf16* WoT = (bf16*)(ws + WS_WO); bf16* WqT = (bf16*)(ws + WS_WQ); bf16* WuvT = (bf16*)(ws + WS_WUV);
    bf16* WpoolT = (bf16*)(ws + WS_WPOOL); bf16* WdT = (bf16*)(ws + WS_WD); bf16* WguT = (bf16*)(ws + WS_WGU);
    bf16* KLs = (bf16*)(ws + WS_KLS);
    constexpr int N_WIN = 16 * 29, N_WO = 16 * 32, N_WD = 44 * 32, N_WG = 16 * 88, N_WPOOL = 32;
    constexpr int NITEMS = N_WIN + N_WO + N_WD + 2 * N_WG + N_WPOOL;
    for (int it = gw; it < NITEMS; it += NGW) {
        int r = it;
        if (r < N_WIN) { const int kb = r / 29, nb = r % 29; tr_item(P.in[I_WIN] + (size_t)(64 * kb) * INW + 32 * nb, INW, nullptr, nullptr, WinT, 1024, 32 * nb, 64 * kb, scr, lane); continue; } r -= N_WIN;
        if (r < N_WO) { const int kb = r / 32, nb = r % 32; tr_item(P.in[I_WO] + (size_t)(64 * kb) * 1024 + 32 * nb, 1024, kb < 8 ? P.in[I_GOA] + 64 * kb : P.in[I_GOP] + 64 * (kb - 8), nullptr, WoT, 1024, 32 * nb, 64 * kb, scr, lane); continue; } r -= N_WO;
        if (r < N_WD) { const int kb = r / 32, nb = r % 32; tr_item(P.in[I_WD] + (size_t)(64 * kb) * 1024 + 32 * nb, 1024, nullptr, nullptr, WdT, DFF, 32 * nb, 64 * kb, scr, lane); continue; } r -= N_WD;
        if (r < 2 * N_WG) { const int up = r >= N_WG; if (up) r -= N_WG; const int kb = r / 88, nb = r % 88; const int n0 = 32 * nb;
            tr_item(P.in[up ? I_WU : I_WG] + (size_t)(64 * kb) * DFF + n0, DFF, P.in[I_GN2] + 64 * kb, nullptr, WguT, 1024, 256 * (n0 >> 7) + (n0 & 127) + (up ? 128 : 0), 64 * kb, scr, lane); continue; } r -= 2 * N_WG;
        if (r < N_WPOOL) { const int g = r >> 3, kb = (r >> 2) & 1, nb = r & 3;
            tr_item(P.in[I_WPOOL] + (size_t)g * 16384 + (size_t)(64 * kb) * 128 + 32 * nb, 128, nullptr, P.in[I_PSCALE] + 128 * g + 32 * nb, WpoolT, 512, 128 * g + 32 * nb, 128 * g + 64 * kb, scr, lane); continue; } r -= N_WPOOL;
    }
    const u32x4 z4 = {0u, 0u, 0u, 0u};
    for (int i = gt; i < 96 * 128; i += GT) ((u32x4*)(WinT + (size_t)928 * 1024))[i] = z4;
    for (int i = gt; i < 512 * 64; i += GT) { const int n = i >> 6, c8 = i & 63; if ((n >> 7) != (c8 >> 4)) ((u32x4*)WpoolT)[i] = z4; }
    for (int i = gt; i < 65536; i += GT) { const int j = i & 7, ln = (i >> 3) & 63, s2 = (i >> 9) & 1, db = (i >> 10) & 3, ddb = (i >> 12) & 1, hd = i >> 13;
        const int dd = 32 * ddb + (ln & 31), r = 32 * db + 16 * s2 + 8 * (j >> 2) + 4 * (ln >> 5) + (j & 3);
        WuvT[i] = (bf16)(pk2(P.in[I_WUV][((size_t)hd * 128 + r) * 64 + dd], 0.f) & 0xffffu); }
    for (int i = gt; i < 8 * 128 * 256; i += GT) {
        const int k = i & 255, r = (i >> 8) & 127, h = i >> 15;
        const f32x4* a = (const f32x4*)(P.in[I_WUQ] + (size_t)k * 768 + h * 96); const f32x4* b = (const f32x4*)(P.in[I_WUK] + ((size_t)h * 128 + r) * 64);
        float s = 0.f;
#pragma unroll 16
        for (int d = 0; d < 16; ++d) { const f32x4 x = a[d], y = b[d]; s += (x[0] * y[0] + x[1] * y[1]) + (x[2] * y[2] + x[3] * y[3]); }
        WqT[(size_t)(160 * h + r) * 256 + k] = (bf16)(pk2(s, 0.f) & 0xffffu);
    }
    for (int i = gt; i < 8 * 32 * 256; i += GT) {
        const int k = i & 255, ii = (i >> 8) & 31, h = i >> 13;
        const int prow = 160 * h + 128 + (ii < 16 ? 2 * ii : 2 * (ii - 16) + 1);
        WqT[(size_t)prow * 256 + k] = (bf16)(pk2(P.in[I_WUQ][(size_t)k * 768 + h * 96 + 64 + ii], 0.f) & 0xffffu);
    }
    {
        float* tab = (float*)(ws + WS_TAB);
        for (int i = gt; i < 8192 * 16; i += GT) {
            const int pos = i >> 4, f = i & 15;
            const int fl = f & 3, fh = f >> 2;
            double fr = fl == 0 ? 1.0 : (fl == 1 ? 0.5623413251903491 : (fl == 2 ? 0.31622776601683794 : 0.17782794100389228));
            fr *= fh == 0 ? 1.0 : (fh == 1 ? 0.1 : (fh == 2 ? 0.01 : 0.001));
            const double rev = (double)pos * fr * 0.15915494309189535;
            const float frac = (float)(rev - __builtin_rint(rev));
            const float cv_ = __builtin_amdgcn_cosf(frac), sv_ = __builtin_amdgcn_sinf(frac);
            tab[2 * i] = cv_; tab[2 * i + 1] = sv_;
            { typedef _Float16 h2_t __attribute__((ext_vector_type(2))); const h2_t hv_ = {(_Float16)cv_, (_Float16)sv_}; ((unsigned*)(ws + WS_TAB16))[i] = __builtin_bit_cast(unsigned, hv_); }
        }
    }
    if (gt < 64) ((unsigned*)(ws + WS_CTL))[gt] = 0u;
    {
        bf16* XN = (bf16*)(ws + WS_A);
        const f32x4* g4 = (const f32x4*)P.in[I_GN1] + lane;
        f32x4 gg[4];
#pragma unroll
        for (int j = 0; j < 4; ++j) gg[j] = g4[64 * j];
        for (int row0 = gw; row0 < NT; row0 += 4 * NGW) {
            f32x4 v[4][4]; int rows[4];
#pragma unroll
            for (int k = 0; k < 4; ++k) { const int row = row0 + k * NGW < NT ? row0 + k * NGW : row0; rows[k] = row;
                const float* xa = row < NTOK_P ? P.in[I_XP] + (size_t)row * DM : P.in[I_XS] + (size_t)(row - NTOK_P) * DM; const f32x4* xr = (const f32x4*)xa + lane;
#pragma unroll
                for (int j = 0; j < 4; ++j) v[k][j] = __builtin_nontemporal_load(xr + 64 * j); }
#pragma unroll
            for (int k = 0; k < 4; ++k) {
                float s = 0.f;
#pragma unroll
                for (int j = 0; j < 4; ++j) s += (v[k][j][0] * v[k][j][0] + v[k][j][1] * v[k][j][1]) + (v[k][j][2] * v[k][j][2] + v[k][j][3] * v[k][j][3]);
                const float rstd = __builtin_amdgcn_rsqf(wave_sum(s) * (1.0f / DM) + EPS);
                u32x2* o = (u32x2*)(XN + (size_t)rows[k] * DM) + lane;
#pragma unroll
                for (int j = 0; j < 4; ++j) { const f32x4 g = gg[j]; u32x2 w; w.x = pk2(v[k][j][0] * rstd * g[0], v[k][j][1] * rstd * g[1]); w.y = pk2(v[k][j][2] * rstd * g[2], v[k][j][3] * rstd * g[3]); o[64 * j] = w; }
            }
        }
    }
    for (int r0 = gw; r0 < 8 * 4096; r0 += 4 * NGW) {
        float2 v[4]; float k1[4], k2[4]; int rr[4];
#pragma unroll
        for (int k = 0; k < 4; ++k) { const int r = r0 + k * NGW < 8 * 4096 ? r0 + k * NGW : r0; rr[k] = r;
            v[k] = *(const float2*)(P.in[I_CKV] + (size_t)r * 128 + 2 * lane); const float* kr = P.in[I_CKR] + (size_t)r * 32; k1[k] = kr[lane & 15]; k2[k] = kr[16 + (lane & 15)]; }
#pragma unroll
        for (int k = 0; k < 4; ++k) { const int b = rr[k] >> 12, j = rr[k] & 4095;
            unsigned* dst = (unsigned*)(KLs + ((size_t)b * SKV + j) * 160); const int sg = (j >> 2) & 3;
            dst[(((lane >> 2) ^ sg) << 2) + (lane & 3)] = pk2(v[k].x, v[k].y);
            if (lane < 16) dst[64 + (((lane >> 2) ^ sg) << 2) + (lane & 3)] = pk2(k1[k], k2[k]); }
    }
}

__device__ __forceinline__ void p2_phase(const Params& P, LAS unsigned char* lds) {
    int tid_l = threadIdx.x; asm volatile("" : "+v"(tid_l)); const int tid = tid_l, lane = tid & 63, wave = tid >> 6;
    unsigned char* ws = P.ws;
    const bf16* Z = (const bf16*)(ws + WS_B);
    bf16* CQ = (bf16*)(ws + WS_CQ); bf16* KLp = (bf16*)(ws + WS_KLP); bf16* KLs = (bf16*)(ws + WS_KLS);
    bf16* POOLED = (bf16*)(ws + WS_POOLED);
    const float* tab = (const float*)(ws + WS_TAB);
    float* out = P.out;
    LAS unsigned char* U = lds + 16384;
    constexpr int UROW = 1040;
    const int grp = lane >> 4, wwin = 2 << grp;
    const u32x4 z4 = {0u, 0u, 0u, 0u};
    const f32x4 gq = *((const f32x4*)P.in[I_GQ] + lane);
    const float2 gkv = *((const float2*)P.in[I_GKV] + lane);
    for (int unit = blockIdx.x; unit < NT / 64; unit += gridDim.x) {
        const bool samp = unit >= 1024;
        if (!samp) {
            const int gr0 = unit * 64, t0 = gr0 & 8191;
#pragma unroll
            for (int it = 0; it < 10; ++it) { const int cc = tid + 512 * it; const int r = cc >> 6, c16 = cc & 63; const int tt = t0 - 15 + r; const bool ok = cc < 79 * 64;
                const int rs = (tt >= 0 && ok) ? gr0 - 15 + r : gr0;
                u32x4 v = *((const u32x4*)(Z + (size_t)rs * 1024 + 416) + c16);
                if (tt < 0) v = z4;
                if (ok) *(LAS u32x4*)(U + r * UROW + c16 * 16) = v; }
        } else {
            const int sj = unit - 1024;
            for (int cc = tid; cc < 94 * 64; cc += NTHREADS) { const int r = cc >> 6, c16 = cc & 63; const int bb = r >= 47 ? 1 : 0, rr = r - 47 * bb; const int b = 2 * sj + bb;
                u32x4 v;
                if (rr < 15) { const f32x4* sp = (const f32x4*)(P.in[I_SPOOL] + ((size_t)b * 15 + rr) * 512) + 2 * c16; const f32x4 a = sp[0], c = sp[1];
                    v.x = pk2(a[0], a[1]); v.y = pk2(a[2], a[3]); v.z = pk2(c[0], c[1]); v.w = pk2(c[2], c[3]); }
                else v = *((const u32x4*)(Z + (size_t)(NTOK_P + b * 32 + rr - 15) * 1024 + 416) + c16);
                *(LAS u32x4*)(U + r * UROW + c16 * 16) = v; }
        }
        u32x2 cqw[8]; unsigned kvw[8]; unsigned k1[8], k2[8]; float2 csv[8];
#pragma unroll
        for (int ii = 0; ii < 8; ++ii) { const int gr_ = unit * 64 + wave * 8 + ii; const bf16* zr = Z + (size_t)gr_ * 1024;
            cqw[ii] = *((const u32x2*)zr + lane); kvw[ii] = *((const unsigned*)(zr + 256) + lane); k1[ii] = zr[384 + (lane & 15)]; k2[ii] = zr[400 + (lane & 15)];
            const int pos_ = samp ? 4096 + ((gr_ - NTOK_P) & 31) : (gr_ & 8191); csv[ii] = *((const float2*)tab + (size_t)pos_ * 16 + (lane & 15)); }
        __syncthreads();
        float ac[8];
#pragma unroll
        for (int ii = 0; ii < 8; ++ii) {
            const int i = wave * 8 + ii; const int gr = unit * 64 + i;
            int b, t, pos, urow; size_t keyrow;
            if (!samp) { b = gr >> 13; t = gr & 8191; pos = t; keyrow = (size_t)gr; urow = 15 + i; }
            else { const int sr = gr - NTOK_P; b = sr >> 5; t = sr & 31; pos = 4096 + t; keyrow = (size_t)b * SKV + 4096 + t; urow = 47 * (i >> 5) + 15 + t; }
            bf16* KL = samp ? KLs : KLp;
            { const u32x2 w = cqw[ii]; const float a0 = bflo(w.x), a1 = bfhi(w.x), a2 = bflo(w.y), a3 = bfhi(w.y);
              const float rstd = __builtin_amdgcn_rsqf(wave_sum((a0 * a0 + a1 * a1) + (a2 * a2 + a3 * a3)) * (1.0f / 256.0f) + EPS);
              u32x2 o; o.x = pk2(a0 * rstd * gq[0], a1 * rstd * gq[1]); o.y = pk2(a2 * rstd * gq[2], a3 * rstd * gq[3]);
              *((u32x2*)(CQ + (size_t)gr * 256) + lane) = o; }
            { const unsigned w = kvw[ii]; const float a0 = bflo(w), a1 = bfhi(w);
              const float rstd = __builtin_amdgcn_rsqf(wave_sum(a0 * a0 + a1 * a1) * (1.0f / 128.0f) + EPS);
              const float v0 = a0 * rstd * gkv.x, v1 = a1 * rstd * gkv.y;
              float* okv = samp ? out + O_KVS + (size_t)(gr - NTOK_P) * 128 : out + O_KVP + (size_t)gr * 128;
              *((float2*)okv + lane) = make_float2(v0, v1);
              const unsigned pw = pk2(v0, v1);
              *((unsigned*)(KL + keyrow * 160) + ((((lane >> 2) ^ ((t >> 2) & 3)) << 2) + (lane & 3))) = pw;
            }
            if (lane < 16) {
                const float x1 = bflo(k1[ii]), x2 = bflo(k2[ii]);
                const float2 cs = csv[ii];
                const float o1 = x1 * cs.x - x2 * cs.y, o2 = x2 * cs.x + x1 * cs.y;
                float* okr = samp ? out + O_KRS + (size_t)(gr - NTOK_P) * 32 : out + O_KRP + (size_t)gr * 32;
                okr[lane] = o1; okr[16 + lane] = o2;
                *((unsigned*)(KL + keyrow * 160 + 128) + ((((lane >> 2) ^ ((t >> 2) & 3)) << 2) + (lane & 3))) = pk2(o1, o2);
            }
            { const LAS unsigned char* up = U + urow * UROW + lane * 16;
              const u32x4 uw = *(const LAS u32x4*)up;
              const float ut[8] = {bflo(uw.x), bfhi(uw.x), bflo(uw.y), bfhi(uw.y), bflo(uw.z), bfhi(uw.z), bflo(uw.w), bfhi(uw.w)};
              if (ii == 0) {
#pragma unroll
                  for (int e = 0; e < 8; ++e) ac[e] = ut[e];
#pragma unroll
                  for (int j = 1; j < 16; ++j) {
                      const u32x4 q = *(const LAS u32x4*)(up - j * UROW);
                      const float m = j < wwin ? 1.0f : 0.0f;
                      ac[0] += m * bflo(q.x); ac[1] += m * bfhi(q.x); ac[2] += m * bflo(q.y); ac[3] += m * bfhi(q.y); ac[4] += m * bflo(q.z); ac[5] += m * bfhi(q.z); ac[6] += m * bflo(q.w); ac[7] += m * bfhi(q.w);
                  }
              } else {
                  const u32x4 q = *(const LAS u32x4*)(up - wwin * UROW);
                  ac[0] += ut[0] - bflo(q.x); ac[1] += ut[1] - bfhi(q.x); ac[2] += ut[2] - bflo(q.y); ac[3] += ut[3] - bfhi(q.y); ac[4] += ut[4] - bflo(q.z); ac[5] += ut[5] - bfhi(q.z); ac[6] += ut[6] - bflo(q.w); ac[7] += ut[7] - bfhi(q.w);
              }
              const int cnt = samp ? wwin : (t + 1 < wwin ? t + 1 : wwin);
              const float ic = 1.0f / (float)cnt;
              u32x4 o; o.x = pk2(ac[0] * ic - ut[0], ac[1] * ic - ut[1]); o.y = pk2(ac[2] * ic - ut[2], ac[3] * ic - ut[3]); o.z = pk2(ac[4] * ic - ut[4], ac[5] * ic - ut[5]); o.w = pk2(ac[6] * ic - ut[6], ac[7] * ic - ut[7]);
              *((u32x4*)(POOLED + (size_t)gr * 512) + lane) = o;
              const int e0 = samp ? t - 17 : t - 8177;
              if (e0 >= 0) { float* op = out + (samp ? O_POOLS : O_POOLP) + ((size_t)b * 15 + e0) * 512; f32x4* o4 = (f32x4*)op + 2 * lane;
                  o4[0] = (f32x4){ut[0], ut[1], ut[2], ut[3]}; o4[1] = (f32x4){ut[4], ut[5], ut[6], ut[7]}; }
            }
        }
        if (samp) {
            const int sj = unit - 1024;
            for (int bb = 0; bb < 2; ++bb) { u32x4* padp = (u32x4*)(KLs + ((size_t)(2 * sj + bb) * SKV + 4128) * 160);
                for (int cc = tid; cc < 640; cc += NTHREADS) padp[cc] = z4; }
        }
        __syncthreads();
    }
}

namespace att {
constexpr int KROW = 320, KT_BYTES = 64 * KROW;
constexpr int KROW_UNUSED = 0;
constexpr float THR = 4.0f;
static_assert(4 * KT_BYTES <= 131072, "attention ring");
}
__device__ __forceinline__ float max3f(float a, float b, float c) { float r; asm("v_max3_f32 %0, %1, %2, %3" : "=v"(r) : "v"(a), "v"(b), "v"(c)); return r; }
__device__ __forceinline__ float max2f(float a, float b) { float r; asm("v_max_f32_e32 %0, %1, %2" : "=v"(r) : "v"(a), "v"(b)); return r; }
#define ATT_SB() __builtin_amdgcn_sched_barrier(0)
#define ATT_DMA(gsrc, ldsdst) __builtin_amdgcn_global_load_lds((const unsigned*)(gsrc), (LAS unsigned*)(ldsdst), 16, 0, 0)
#define ATT_WAITBAR(n) asm volatile("s_waitcnt vmcnt(" #n ") lgkmcnt(0)\n\ts_barrier" ::: "memory")

template <bool QK, bool PV>
__device__ __forceinline__ void att_step(f32x16& C0, f32x16& C1, f32x16& negm, const u32x4 (&pw)[2][2], u32x4 (&pn)[2][2], f32x16 (&o)[4], float& mhat, float& lrun, const bf16x8 (&qf)[10],
                                         const LAS unsigned char* kp, const LAS unsigned char* vp, bool maskC1, int ke, int ko, int vd) {
    using namespace att;
    constexpr int D = 4;
    if (QK) {
        bf16x8 fr[D];
#pragma unroll
        for (int i = 0; i < D; ++i) fr[i] = *(const LAS bf16x8*)(kp + (i & 1) * 32 * KROW + ((i >> 1) >> 1) * 64 + (((i >> 1) & 1) ? ko : ke));
#pragma unroll
        for (int i = 0; i < 20; ++i) {
            const int ks = i >> 1;
            const bf16x8 a = fr[i % D];
            if (i & 1) { if (ks == 0) { const f32x16 z = {0.f, 0.f, 0.f, 0.f, 0.f, 0.f, 0.f, 0.f, 0.f, 0.f, 0.f, 0.f, 0.f, 0.f, 0.f, 0.f}; C1 = __builtin_amdgcn_mfma_f32_32x32x16_bf16(a, qf[0], PV ? negm : z, 0, 0, 0); }
                         else C1 = __builtin_amdgcn_mfma_f32_32x32x16_bf16(a, qf[ks], C1, 0, 0, 0); }
            else       { if (ks == 0) { const f32x16 z = {0.f, 0.f, 0.f, 0.f, 0.f, 0.f, 0.f, 0.f, 0.f, 0.f, 0.f, 0.f, 0.f, 0.f, 0.f, 0.f}; C0 = __builtin_amdgcn_mfma_f32_32x32x16_bf16(a, qf[0], PV ? negm : z, 0, 0, 0); }
                         else C0 = __builtin_amdgcn_mfma_f32_32x32x16_bf16(a, qf[ks], C0, 0, 0, 0); }
            if (i + D < 20) { const int j = i + D; fr[i % D] = *(const LAS bf16x8*)(kp + (j & 1) * 32 * KROW + ((j >> 1) >> 1) * 64 + (((j >> 1) & 1) ? ko : ke)); }
#ifdef PROBE_LDS2
            { }
#endif
            ATT_SB();
        }
    }
#define ATT_VFRAG(i_) ({ const LAS unsigned char* p_ = vp + (32 * (((i_) >> 2) >> 1) + 16 * (((i_) >> 2) & 1)) * KROW + ((i_) & 3) * 64; \
        const s16x4 lo_ = __builtin_bit_cast(s16x4, __builtin_amdgcn_ds_read_tr16_b64_v4i16((LAS v4i16_t*)p_)); const s16x4 hi_ = __builtin_bit_cast(s16x4, __builtin_amdgcn_ds_read_tr16_b64_v4i16((LAS v4i16_t*)(p_ + vd))); \
        (bf16x8){lo_[0], lo_[1], lo_[2], lo_[3], hi_[0], hi_[1], hi_[2], hi_[3]}; })
    bf16x8 vr[D];
    if (PV) {
#pragma unroll
        for (int i = 0; i < D; ++i) vr[i] = ATT_VFRAG(i);
    }
    bool resc = false; float f = 1.f;
    if (QK) {
        asm volatile("s_nop 15\n\ts_nop 7" : "+v"(C0), "+v"(C1));
        if (maskC1) { asm volatile("" ::: "memory");
#pragma unroll
            for (int r = 0; r < 16; ++r) C1[r] = -1e30f; }
        float a = max3f(C0[0], C0[1], C0[2]), b = max3f(C0[3], C0[4], C0[5]), c4 = max3f(C1[0], C1[1], C1[2]), d4 = max3f(C1[3], C1[4], C1[5]);
        a = max3f(a, C0[6], C0[7]); b = max3f(b, C0[8], C0[9]); c4 = max3f(c4, C1[6], C1[7]); d4 = max3f(d4, C1[8], C1[9]);
        a = max3f(a, C0[10], C0[11]); b = max3f(b, C0[12], C0[13]); c4 = max3f(c4, C1[10], C1[11]); d4 = max3f(d4, C1[12], C1[13]);
        a = max3f(a, C0[14], C0[15]); c4 = max3f(c4, C1[14], C1[15]);
        float rm = max2f(max2f(a, b), max2f(c4, d4)); { auto rr = __builtin_amdgcn_permlane32_swap(__float_as_uint(rm), __float_as_uint(rm), false, false); rm = max2f(__uint_as_float(rr[0]), __uint_as_float(rr[1])); }
        if (!PV) { mhat = rm; }
        else if (__any(rm > THR)) {
            const float dl = max2f(rm, 0.f); f = __builtin_amdgcn_exp2f(-dl); mhat += dl; resc = true;
#pragma unroll
            for (int r = 0; r < 16; ++r) { C0[r] -= dl; C1[r] -= dl; negm[r] = -mhat; } }
    }
    ATT_SB();
    float mh = mhat; float sacc = 0.f;
    if (PV) {
#pragma unroll
        for (int i = 0; i < 16; ++i) {
            const int db = i & 3, combo = i >> 2, kk = combo >> 1, s2 = combo & 1;
            o[db] = __builtin_amdgcn_mfma_f32_32x32x16_bf16(vr[i % D], __builtin_bit_cast(bf16x8, pw[kk][s2]), o[db], 0, 0, 0);
            if (i + D < 16) { vr[i % D] = ATT_VFRAG(i + D); }
#ifdef PROBE_LDS2
            { const bf16x8 dmy = ATT_VFRAG(i); asm volatile("" :: "v"(dmy)); }
#endif
            if (QK) { f32x16& X = (i < 8) ? C0 : C1; const int e = i & 7; const float p0 = __builtin_amdgcn_exp2f(X[2 * e]), p1 = __builtin_amdgcn_exp2f(X[2 * e + 1]);
                X[2 * e] = p0; X[2 * e + 1] = p1; sacc += p0 + p1; unsigned pkw = pk2v(p0, p1);
                asm volatile("" : "+v"(X), "+v"(sacc), "+v"(pkw));
                pn[i >> 3][e >> 2][e & 3] = pkw; }
            ATT_SB();
        }
    } else if (QK) {
#pragma unroll
        for (int i = 0; i < 16; ++i) { const f32x16& X = (i < 8) ? C0 : C1; const int e = i & 7; const float p0 = __builtin_amdgcn_exp2f(X[2 * e] - mh), p1 = __builtin_amdgcn_exp2f(X[2 * e + 1] - mh);
            sacc += p0 + p1; pn[i >> 3][e >> 2][e & 3] = pk2v(p0, p1); }
#pragma unroll
        for (int r = 0; r < 16; ++r) negm[r] = -mh;
    }
    if (QK) lrun = lrun * f + sacc;
    if (resc) {
#pragma unroll
        for (int db = 0; db < 4; ++db)
#pragma unroll
            for (int r = 0; r < 16; ++r) o[db][r] *= f;
    }
}

__device__ __forceinline__ void attn_phase(const Params& P, LAS unsigned char* lds, int cw = 0) {
    using namespace att;
    int tid_l = threadIdx.x; asm volatile("" : "+v"(tid_l)); const int tid = tid_l, lane = tid & 63, w = __builtin_amdgcn_readfirstlane(tid >> 6), q = lane & 31, h = lane >> 5;
    unsigned char* ws = P.ws;
    const bf16* QL = (const bf16*)(ws + WS_QL); const bf16* KLp = (const bf16*)(ws + WS_KLP); const bf16* KLs = (const bf16*)(ws + WS_KLS);
    bf16* OAo = (bf16*)(ws + WS_B);
    const bool xq = (gridDim.x & 7) == 0;
    const int queue = xq ? (int)(blockIdx.x & 7) : 0;
    unsigned* counter = (unsigned*)(ws + WS_CTL) + cw * 16 + queue;
    const unsigned nunits = xq ? 257u : 2056u;
    LAS unsigned* bcast = (LAS unsigned*)(lds + 131072);
    const LAS unsigned char* kread = lds + q * KROW;
    const int kg = (q >> 2) & 3, ke = ((h) ^ kg) * 16, ko = ((2 + h) ^ kg) * 16;
    const int tq = (lane & 15) >> 2, tp = lane & 3, tb = (lane >> 4) & 1, tc = 2 * tb + (tp >> 1);
    const LAS unsigned char* vread = lds + (4 * h + tq) * KROW + ((tc ^ h) << 4) + 8 * (tp & 1);
    const int vd = 8 * KROW + (((tc ^ (h ^ 2)) - (tc ^ h)) << 4);
    const int kc = w < 4 ? 3 : 2;
    if (w >= 4) __builtin_amdgcn_s_setprio(1);
    for (;;) {
        if (tid == 0) bcast[0] = atomicAdd(counter, 1u);
        __syncthreads();
        const unsigned u = __builtin_amdgcn_readfirstlane(bcast[0]);
        if (u >= nunits) break;
        int row0, nt, b; bool samp;
        if (xq) { b = queue; if (u == 0u) { samp = true; row0 = NTOK_P + 32 * b; nt = 65; } else { const int p = (int)u - 1, c = 127 - (p >> 1); samp = false; row0 = b * 8192 + 64 * c + 32 * (p & 1); nt = c + 1; } }
        else if (u < 8u) { b = (int)u; samp = true; row0 = NTOK_P + 32 * b; nt = 65; }
        else { const int up = (int)u - 8, c = 127 - (up >> 4); b = (up & 15) >> 1; samp = false; row0 = b * 8192 + 64 * c + 32 * (up & 1); nt = c + 1; }
        const char* gKu = (const char*)(samp ? KLs + (size_t)b * SKV * 160 : KLp + (size_t)b * 8192 * 160);
        const unsigned loff = (unsigned)(lane * 16 + w * 1024);
        LAS unsigned char* dK = lds + w * 1024;
        { unsigned lo0 = loff; asm volatile("" : "+v"(lo0));
          for (int j = 0; j < kc; ++j) ATT_DMA(gKu + (size_t)(j * 8192) + lo0, dK + j * 8192);
          if (nt > 1) for (int j = 0; j < kc; ++j) ATT_DMA(gKu + (size_t)(KT_BYTES + j * 8192) + lo0, dK + KT_BYTES + j * 8192); }
        bf16x8 qf[10];
        { const bf16* qp = QL + (size_t)(row0 + q) * 1280 + w * 160 + 8 * h;
#pragma unroll
          for (int ks = 0; ks < 10; ++ks) qf[ks] = *(const bf16x8*)(qp + 16 * ks); }
        f32x16 o[4];
#pragma unroll
        for (int db = 0; db < 4; ++db)
#pragma unroll
            for (int r = 0; r < 16; ++r) o[db][r] = 0.f;
        float mhat = 0.f, lrun = 0.f;
        f32x16 C0, C1, negm; u32x4 pa[2][2], pb[2][2];
        ATT_WAITBAR(0);
#define ATT_STEP_ARGS(t) kread + ((t) & 3) * KT_BYTES, vread + (((t) + 3) & 3) * KT_BYTES, samp && ((t) == nt - 1), ke, ko, vd
#define ATT_STEP_DMA(t) do { if ((t) + 2 < nt) { unsigned lo_ = loff; asm volatile("" : "+v"(lo_)); const char* g_ = gKu + (size_t)((t) + 2) * KT_BYTES + lo_; LAS unsigned char* d_ = dK + (((t) + 2) & 3) * KT_BYTES; for (int j_ = 0; j_ < kc; ++j_) ATT_DMA(g_ + (size_t)(j_ * 8192), d_ + j_ * 8192); } } while (0)
#define ATT_STEP_END(t) do { if ((t) + 2 < nt) { if (w < 4) ATT_WAITBAR(3); else ATT_WAITBAR(2); } else ATT_WAITBAR(0); } while (0)
        ATT_STEP_DMA(0);
        att_step<true, false>(C0, C1, negm, pa, pb, o, mhat, lrun, qf, ATT_STEP_ARGS(0));
        ATT_STEP_END(0);
        for (int t = 1; t < nt; ++t) {
            ATT_STEP_DMA(t);
            att_step<true, true>(C0, C1, negm, pb, pa, o, mhat, lrun, qf, ATT_STEP_ARGS(t));
            ATT_STEP_END(t);
#pragma unroll
            for (int x = 0; x < 2; ++x)
#pragma unroll
                for (int y = 0; y < 2; ++y) pb[x][y] = pa[x][y];
        }
        att_step<false, true>(C0, C1, negm, pb, pa, o, mhat, lrun, qf, kread, vread + ((nt + 3) & 3) * KT_BYTES, false, ke, ko, vd);
        lrun += __shfl_xor(lrun, 32);
        const float inv = 1.0f / lrun;
        f32x16 y0, y1;
#pragma unroll
        for (int r = 0; r < 16; ++r) { y0[r] = 0.f; y1[r] = 0.f; }
        { const bf16x8* wf = (const bf16x8*)(ws + WS_WUV) + (size_t)w * 16 * 64 + lane;
#pragma unroll
          for (int db = 0; db < 4; ++db)
#pragma unroll
            for (int s2 = 0; s2 < 2; ++s2) {
                u32x4 pk;
#pragma unroll
                for (int k2 = 0; k2 < 4; ++k2) pk[k2] = pk2v(o[db][8 * s2 + 2 * k2] * inv, o[db][8 * s2 + 2 * k2 + 1] * inv);
                const bf16x8 bfr = __builtin_bit_cast(bf16x8, pk);
                y0 = __builtin_amdgcn_mfma_f32_32x32x16_bf16(wf[((0 * 4 + db) * 2 + s2) * 64], bfr, y0, 0, 0, 0);
                y1 = __builtin_amdgcn_mfma_f32_32x32x16_bf16(wf[((1 * 4 + db) * 2 + s2) * 64], bfr, y1, 0, 0, 0);
            } }
        bf16* op = OAo + (size_t)(row0 + q) * 1024 + w * 64 + 4 * h;
        float ssq = 0.f;
#pragma unroll
        for (int rg = 0; rg < 4; ++rg) {
            u32x2 wv; wv.x = pk2v(y0[4 * rg], y0[4 * rg + 1]); wv.y = pk2v(y0[4 * rg + 2], y0[4 * rg + 3]); *(u32x2*)(op + 8 * rg) = wv;
            u32x2 wz; wz.x = pk2v(y1[4 * rg], y1[4 * rg + 1]); wz.y = pk2v(y1[4 * rg + 2], y1[4 * rg + 3]); *(u32x2*)(op + 32 + 8 * rg) = wz;
#pragma unroll
            for (int e2 = 0; e2 < 4; ++e2) ssq += y0[4 * rg + e2] * y0[4 * rg + e2] + y1[4 * rg + e2] * y1[4 * rg + e2]; }
        ssq += __shfl_xor(ssq, 32);
        LAS float* sA = (LAS float*)(lds + 131072 + 128);
        if (h == 0) sA[w * 32 + q] = ssq;
        __syncthreads();
        if (tid < 32) { float sa = 0.f;
#pragma unroll
            for (int ww = 0; ww < 8; ++ww) sa += sA[ww * 32 + tid];
            const f32x4* sp4 = (const f32x4*)((const float*)(ws + WS_SSP) + (size_t)(row0 + tid) * 8); const f32x4 p0 = sp4[0], p1 = sp4[1];
            const float spv = ((p0[0] + p0[1]) + (p0[2] + p0[3])) + ((p1[0] + p1[1]) + (p1[2] + p1[3]));
            const float ra = __builtin_amdgcn_rsqf(sa * (1.0f / 512.0f) + EPS), rpv = __builtin_amdgcn_rsqf(spv * (1.0f / 512.0f) + EPS);
            ((float*)(ws + WS_RP))[row0 + tid] = rpv; ((float*)(ws + WS_RATIO))[row0 + tid] = ra / rpv; }
    }
    __builtin_amdgcn_s_setprio(0);
#undef ATT_STEP_ARGS
#undef ATT_STEP_DMA
#undef ATT_STEP_END
}

__device__ __forceinline__ void final_norm_phase(const Params& P, int rbeg) {
    int tid_l = threadIdx.x; asm volatile("" : "+v"(tid_l)); const int tid = tid_l, lane = tid & 63, wave = tid >> 6;
    const int gw = blockIdx.x * 8 + wave, NGW = gridDim.x * 8;
    const f32x4* g4 = (const f32x4*)P.in[I_GF] + lane;
    f32x4 gg[4];
#pragma unroll
    for (int j = 0; j < 4; ++j) gg[j] = g4[64 * j];
    for (int row0 = rbeg + gw; row0 < NT; row0 += 2 * NGW) {
        f32x4 v[2][4]; f32x4* y[2];
#pragma unroll
        for (int k = 0; k < 2; ++k) { const int row = row0 + k * NGW < NT ? row0 + k * NGW : row0; y[k] = (f32x4*)(P.out + (size_t)row * 1024) + lane;
#pragma unroll
            for (int j = 0; j < 4; ++j) v[k][j] = y[k][64 * j]; }
#pragma unroll
        for (int k = 0; k < 2; ++k) {
            float sq = 0.f;
#pragma unroll
            for (int j = 0; j < 4; ++j) sq += (v[k][j][0] * v[k][j][0] + v[k][j][1] * v[k][j][1]) + (v[k][j][2] * v[k][j][2] + v[k][j][3] * v[k][j][3]);
            const float r = __builtin_amdgcn_rsqf(wave_sum(sq) * (1.0f / 1024.0f) + EPS);
            if (k == 0 || row0 + NGW < NT) {
#pragma unroll
                for (int j = 0; j < 4; ++j) y[k][64 * j] = v[k][j] * r * gg[j]; }
        }
    }
}

__device__ __forceinline__ int crow16(int r, int hi) { return (r & 3) + 8 * (r >> 2) + 4 * hi; }
template <class F>
__device__ __forceinline__ void mini_gemm(LAS unsigned char* lds, const bf16* A, const bf16* Bt, int K, int N, const F& epi) {
    int tid_l = threadIdx.x; asm volatile("" : "+v"(tid_l)); const int tid = tid_l, lane = tid & 63, w = __builtin_amdgcn_readfirstlane(tid >> 6), j = lane & 31, h = lane >> 5;
    const int ncb = N / 64, nblk = 8 * ncb, kw = K / 8;
    LAS float* part = (LAS float*)lds;
    for (int blk = blockIdx.x; blk < nblk; blk += gridDim.x) {
        const int rb = blk / ncb, cb = blk % ncb;
        const bf16* ap = A + (size_t)(32 * rb + j) * K + w * kw + 8 * h;
        const bf16* b0 = Bt + (size_t)(64 * cb + j) * K + w * kw + 8 * h; const bf16* b1 = b0 + (size_t)32 * K;
        f32x16 c0, c1;
#pragma unroll
        for (int r = 0; r < 16; ++r) { c0[r] = 0.f; c1[r] = 0.f; }
        for (int s2 = 0; s2 < kw; s2 += 64) {
            bf16x8 af[4], xf[4], yf[4];
#pragma unroll
            for (int u4 = 0; u4 < 4; ++u4) if (s2 + 16 * u4 < kw) { af[u4] = *(const bf16x8*)(ap + s2 + 16 * u4); xf[u4] = *(const bf16x8*)(b0 + s2 + 16 * u4); yf[u4] = *(const bf16x8*)(b1 + s2 + 16 * u4); }
#pragma unroll
            for (int u4 = 0; u4 < 4; ++u4) if (s2 + 16 * u4 < kw) { c0 = __builtin_amdgcn_mfma_f32_32x32x16_bf16(af[u4], xf[u4], c0, 0, 0, 0); c1 = __builtin_amdgcn_mfma_f32_32x32x16_bf16(af[u4], yf[u4], c1, 0, 0, 0); }
        }
#pragma unroll
        for (int r = 0; r < 16; ++r) { LAS float* pr = part + (w * 32 + crow16(r, h)) * 64 + j; pr[0] = c0[r]; pr[32] = c1[r]; }
        __syncthreads();
        const int r_out = tid >> 4, c4 = tid & 15;
        f32x4 alo = {0.f, 0.f, 0.f, 0.f}, ahi = {0.f, 0.f, 0.f, 0.f};
#pragma unroll
        for (int ww = 0; ww < 4; ++ww) { alo += *(const LAS f32x4*)(part + (ww * 32 + r_out) * 64 + 4 * c4); ahi += *(const LAS f32x4*)(part + ((ww + 4) * 32 + r_out) * 64 + 4 * c4); }
        epi(32 * rb + r_out, 64 * cb + 4 * c4, alo, ahi);
        __syncthreads();
    }
}
__device__ __forceinline__ void mini_gateup(LAS unsigned char* lds, const bf16* A, const bf16* WguT, const float* ss  , bf16* H  ) {
    int tid_l = threadIdx.x; asm volatile("" : "+v"(tid_l)); const int tid = tid_l, lane = tid & 63, w = __builtin_amdgcn_readfirstlane(tid >> 6), j = lane & 31, h = lane >> 5;
    constexpr int K = 1024, kw = K / 8, ncb = DFF / 32, nblk = 8 * ncb;
    LAS float* part = (LAS float*)lds;
    for (int blk = blockIdx.x; blk < nblk; blk += gridDim.x) {
        const int rb = blk / ncb, cb = blk % ncb, c0 = 32 * cb;
        const bf16* ap = A + (size_t)(32 * rb + j) * K + w * kw + 8 * h;
        const bf16* b0 = WguT + (size_t)(256 * (c0 >> 7) + (c0 & 127) + j) * K + w * kw + 8 * h; const bf16* b1 = b0 + (size_t)128 * K;
        f32x16 a0, a1;
#pragma unroll
        for (int r = 0; r < 16; ++r) { a0[r] = 0.f; a1[r] = 0.f; }
#pragma unroll
        for (int s2 = 0; s2 < kw; s2 += 16) { const bf16x8 a = *(const bf16x8*)(ap + s2), x = *(const bf16x8*)(b0 + s2), y = *(const bf16x8*)(b1 + s2);
            a0 = __builtin_amdgcn_mfma_f32_32x32x16_bf16(a, x, a0, 0, 0, 0); a1 = __builtin_amdgcn_mfma_f32_32x32x16_bf16(a, y, a1, 0, 0, 0); }
#pragma unroll
        for (int r = 0; r < 16; ++r) { LAS float* pr = part + (w * 32 + crow16(r, h)) * 64 + j; pr[0] = a0[r]; pr[32] = a1[r]; }
        __syncthreads();
        const int r_out = tid >> 4, c4 = tid & 15;
        if (c4 < 8) {
            f32x4 g = {0.f, 0.f, 0.f, 0.f}, u = {0.f, 0.f, 0.f, 0.f};
#pragma unroll
            for (int ww = 0; ww < 8; ++ww) { g += *(const LAS f32x4*)(part + (ww * 32 + r_out) * 64 + 4 * c4); u += *(const LAS f32x4*)(part + (ww * 32 + r_out) * 64 + 32 + 4 * c4); }
            const int row = 32 * rb + r_out;
            const f32x4* sp = (const f32x4*)(ss + (size_t)row * 16); const f32x4 sa = (sp[0] + sp[1]) + (sp[2] + sp[3]);
            const float r = __builtin_amdgcn_rsqf(((sa[0] + sa[1]) + (sa[2] + sa[3])) * (1.0f / 1024.0f) + EPS);
            float hv[4];
#pragma unroll
            for (int e = 0; e < 4; ++e) { const float gg = g[e] * r; hv[e] = gg * __builtin_amdgcn_rcpf(1.0f + __builtin_amdgcn_exp2f(-1.4426950408889634f * gg)) * (u[e] * r); }
            u32x2 wv; wv.x = pk2(hv[0], hv[1]); wv.y = pk2(hv[2], hv[3]);
            *(u32x2*)(H + (size_t)row * DFF + c0 + 4 * c4) = wv;
        }
        __syncthreads();
    }
}
struct MiniBf16 { bf16* O; int ldc; float* ss;
    __device__ __forceinline__ void operator()(int row, int col, f32x4 lo, f32x4 hi) const { const f32x4 v = lo + hi; u32x2 w; w.x = pk2(v[0], v[1]); w.y = pk2(v[2], v[3]); *(u32x2*)(O + (size_t)row * ldc + col) = w;
        if (ss) { float s = (v[0] * v[0] + v[1] * v[1]) + (v[2] * v[2] + v[3] * v[3]); s += __shfl_xor(s, 1); s += __shfl_xor(s, 2); s += __shfl_xor(s, 4); s += __shfl_xor(s, 8);
            if ((threadIdx.x & 15) == 0) ss[(size_t)row * 8 + (col >> 6)] = s; } } };
struct MiniQRope { bf16* O; const float* tab; float scale;
    __device__ __forceinline__ void operator()(int row, int col, f32x4 lo, f32x4 hi) const {
        f32x4 v = lo + hi; const int cm = col % 160;
        if (cm >= 128) { const int pos = 4096 + (row & 31), ip = (cm - 128) >> 1; const f32x4 t = *(const f32x4*)(tab + ((size_t)pos * 16 + ip) * 2);
            const float a0 = v[0], b0 = v[1], a1 = v[2], b1 = v[3]; v[0] = a0 * t[0] - b0 * t[1]; v[1] = b0 * t[0] + a0 * t[1]; v[2] = a1 * t[2] - b1 * t[3]; v[3] = b1 * t[2] + a1 * t[3]; }
        v = v * scale; u32x2 w; w.x = pk2(v[0], v[1]); w.y = pk2(v[2], v[3]); *(u32x2*)(O + (size_t)row * 1280 + col) = w; } };
template <bool WO> struct MiniRes { const float* xs; float* out; bf16* xb; float* ss; const float* ratio; const float* rp;
    __device__ __forceinline__ void operator()(int row, int col, f32x4 lo, f32x4 hi) const {
        const f32x4 acc = WO ? (lo * ratio[row] + hi) * rp[row] : lo + hi;
        float* dst = out + (size_t)row * 1024 + col; const f32x4 base = WO ? *(const f32x4*)(xs + (size_t)row * 1024 + col) : *(const f32x4*)dst;
        const f32x4 v = base + acc; *(f32x4*)dst = v;
        if (WO) { u32x2 w; w.x = pk2(v[0], v[1]); w.y = pk2(v[2], v[3]); *(u32x2*)(xb + (size_t)row * 1024 + col) = w;
            float s = (v[0] * v[0] + v[1] * v[1]) + (v[2] * v[2] + v[3] * v[3]); s += __shfl_xor(s, 1); s += __shfl_xor(s, 2); s += __shfl_xor(s, 4); s += __shfl_xor(s, 8);
            if ((threadIdx.x & 15) == 0) ss[(size_t)row * 16 + (col >> 6)] = s; } } };

#define XB_TMO      128
#define XB_XCNT(j)  (256  + 64 * (j))
#define XB_XSUB(j)  (1280 + 64 * (j))
#define XB_XGEN(j)  (2304 + 64 * (j))
#define XB_TOP      3328
#define XB_TOPGEN   3392
#define XCD_BAR_WORDS 3456
#define XB_SPIN_CAP (1u << 18)

__device__ __forceinline__ unsigned xb_ld(unsigned* p)              { return __hip_atomic_load(p, __ATOMIC_RELAXED, __HIP_MEMORY_SCOPE_AGENT); }
__device__ __forceinline__ unsigned xb_add(unsigned* p, unsigned v) { return __hip_atomic_fetch_add(p, v, __ATOMIC_RELAXED, __HIP_MEMORY_SCOPE_AGENT); }
__device__ __forceinline__ unsigned xb_xcc_id() { return (unsigned)__builtin_amdgcn_s_getreg((3 << 11) | 20) & 0xFu; }
#define XB_SPIN(cond, bar) do { unsigned _sp = 0; while (cond) { __builtin_amdgcn_s_sleep(1); \
    if ((++_sp & 255u) == 0u) { if (xb_ld(&(bar)[XB_TMO])) break; if (_sp > XB_SPIN_CAP) { atomicAdd(&(bar)[XB_TMO], 1u); break; } } } } while (0)

struct XcdBarrier {
    unsigned* bar; unsigned x;
    volatile LAS unsigned* st;
};

__device__ __forceinline__ XcdBarrier xcd_barrier_post(unsigned* bar, volatile LAS unsigned* st) {
    XcdBarrier b; b.bar = bar; b.x = xb_xcc_id(); b.st = st;
    if (threadIdx.x == 0) (void)xb_add(&bar[XB_XCNT(b.x)], 1u);
    return b;
}
__device__ __forceinline__ void xcd_barrier_complete(unsigned* bar, unsigned x, unsigned& nloc, unsigned& nx) {
    const unsigned G = gridDim.x * gridDim.y * gridDim.z;
    unsigned sum, cnt, mine, sp = 0u;
    for (;;) {
        sum = 0u; cnt = 0u; mine = 0u;
#pragma unroll
        for (unsigned j = 0; j < 16; ++j) { const unsigned c = xb_ld(&bar[XB_XCNT(j)]); sum += c; cnt += (c > 0u) ? 1u : 0u; mine = (j == x) ? c : mine; }
        if (sum == G) break;
        __builtin_amdgcn_s_sleep(1);
        if ((++sp & 255u) == 0u) { if (xb_ld(&bar[XB_TMO])) break; if (sp > XB_SPIN_CAP) { atomicAdd(&bar[XB_TMO], 1u); break; } }
    }
    nloc = mine > 0u ? mine : 1u; nx = cnt > 0u ? cnt : 1u;
}

__device__ __forceinline__ void xcd_barrier(const XcdBarrier& b) {
    asm volatile("s_waitcnt vmcnt(0)" ::: "memory");
    __syncthreads();
    if (threadIdx.x == 0) {
        unsigned* bar = b.bar;
        __builtin_amdgcn_s_waitcnt(0);
        unsigned nloc = b.st[0], nx = b.st[1];
        if (nloc == 0u) { xcd_barrier_complete(bar, b.x, nloc, nx); b.st[0] = nloc; b.st[1] = nx; }
        const unsigned old = xb_add(&bar[XB_XSUB(b.x)], 1u);
        const unsigned gen = old / nloc;
        if (old + 1u == (gen + 1u) * nloc) {
            __builtin_amdgcn_fence(__ATOMIC_RELEASE, "agent");
            asm volatile("s_waitcnt vmcnt(0)" ::: "memory");
            const unsigned og = xb_add(&bar[XB_TOP], 1u);
            const unsigned tg = og / nx;
            if (og + 1u == (tg + 1u) * nx) xb_add(&bar[XB_TOPGEN], 1u);
            else XB_SPIN(xb_ld(&bar[XB_TOPGEN]) == tg, bar);
            __builtin_amdgcn_fence(__ATOMIC_ACQUIRE, "agent");
            xb_add(&bar[XB_XGEN(b.x)], 1u);
            asm volatile("s_waitcnt vmcnt(0)" ::: "memory");
        } else {
            XB_SPIN(xb_ld(&bar[XB_XGEN(b.x)]) == gen, bar);
            __builtin_amdgcn_fence(__ATOMIC_ACQUIRE, "agent");
            asm volatile("s_waitcnt vmcnt(0)" ::: "memory");
        }
    }
    __syncthreads();
}

__global__ void __launch_bounds__(NTHREADS, 2) mk_fwd(Params P) {
    extern __shared__ __attribute__((aligned(16))) unsigned char lds_raw[];
    LAS unsigned char* lds = (LAS unsigned char*)lds_raw;
    cg::grid_group grid = cg::this_grid();
    { volatile LAS unsigned* st0 = (volatile LAS unsigned*)(lds + 131072 + 64); if (threadIdx.x < 2) st0[threadIdx.x] = 0u; __syncthreads(); }
    XcdBarrier xbar = xcd_barrier_post((unsigned*)(P.ws + WS_CTL) + 4096, (volatile LAS unsigned*)(lds + 131072 + 64));
    unsigned char* ws = P.ws;
    const int G = gridDim.x, c = blockIdx.x;
    using pg8::Gemm; using pg8::StaticOrder; using pg8::EpiBf16; using pg8::EpiQRope; using pg8::EpiRes; using pg8::EpiGateUp; using pg8::gemm_phase; using pg8::bf16_t;
    bf16_t* RA = (bf16_t*)(ws + WS_A); bf16_t* RB = (bf16_t*)(ws + WS_B);

#ifndef NO_P0
    p0_prologue(P, lds);
#ifdef PROBE_P0P2
    __syncthreads(); p0_prologue(P, lds);
#endif
#endif
    if (P.ws == nullptr) grid.sync();
    xcd_barrier(xbar);
    { MiniBf16 ME{RB + (size_t)NTOK_P * 1024, 1024, nullptr}; mini_gemm(lds, RA + (size_t)NTOK_P * 1024, (const bf16*)(ws + WS_WIN), 1024, 1024, ME); }
    { Gemm g{RA, (const bf16_t*)(ws + WS_WIN), NTOK_P, 1024, 1024}; StaticOrder S; S.init(NTOK_P, 1024, G, c); EpiBf16 E{RB, 1024, nullptr};
#ifndef NO_G1
      gemm_phase<EpiBf16, StaticOrder, true, true>(lds, g, S, E);
#endif
    }
    xcd_barrier(xbar);
#ifndef NO_P2
    p2_phase(P, lds);
#ifdef PROBE_P0P2
    __syncthreads(); p2_phase(P, lds);
#endif
#ifdef PROBE_SYNC
    for (int i_ = 0; i_ < 10; ++i_) xcd_barrier(xbar);
#endif
#endif
    xcd_barrier(xbar);
    { MiniQRope ME{(bf16*)(ws + WS_QL) + (size_t)NTOK_P * 1280, (const float*)(ws + WS_TAB), QSCALE}; mini_gemm(lds, (const bf16*)(ws + WS_CQ) + (size_t)NTOK_P * 256, (const bf16*)(ws + WS_WQ), 256, 1280, ME); }
    { MiniBf16 ME{RB + (size_t)NTOK_P * 1024 + 512, 1024, (float*)(ws + WS_SSP) + (size_t)NTOK_P * 8}; mini_gemm(lds, (const bf16*)(ws + WS_POOLED) + (size_t)NTOK_P * 512, (const bf16*)(ws + WS_WPOOL), 512, 512, ME); }
    { Gemm g{(const bf16_t*)(ws + WS_CQ), (const bf16_t*)(ws + WS_WQ), NTOK_P, 1280, 256}; StaticOrder S; S.init(NTOK_P, 1280, G, c); EpiQRope E{(bf16_t*)(ws + WS_QL), (const unsigned*)(ws + WS_TAB16), QSCALE};
#ifndef NO_G3
      gemm_phase<EpiQRope, StaticOrder, true, true>(lds, g, S, E);
#endif
    }
    { Gemm g{(const bf16_t*)(ws + WS_POOLED), (const bf16_t*)(ws + WS_WPOOL), NTOK_P, 512, 512}; StaticOrder S; S.init(NTOK_P, 512, G, (c + G - 8) % G); EpiBf16 E{RB + 512, 1024, (float*)(ws + WS_SSP)};
#ifndef NO_G3B
      gemm_phase<EpiBf16, StaticOrder, true, true>(lds, g, S, E);
#endif
    }
    xcd_barrier(xbar);
#ifndef NO_ATT
    attn_phase(P, lds);
#ifdef PROBE_ATT2
    __syncthreads(); attn_phase(P, lds, 1);
#endif
#endif
    xcd_barrier(xbar);
    { MiniRes<true> ME{P.in[I_XS], P.out + (size_t)NTOK_P * 1024, RA + (size_t)NTOK_P * 1024, (float*)(ws + WS_SS2) + (size_t)NTOK_P * 16, (const float*)(ws + WS_RATIO) + NTOK_P, (const float*)(ws + WS_RP) + NTOK_P}; mini_gemm(lds, RB + (size_t)NTOK_P * 1024, (const bf16*)(ws + WS_WO), 1024, 1024, ME); }
    { Gemm g{RB, (const bf16_t*)(ws + WS_WO), NTOK_P, 1024, 1024}; StaticOrder S; S.init(NTOK_P, 1024, G, c);
      EpiRes<true> E{P.in[I_XP], P.in[I_XS], P.out, RA, (float*)(ws + WS_SS2), (const float*)(ws + WS_RATIO), (const float*)(ws + WS_RP)};
#ifndef NO_G7
      gemm_phase<EpiRes<true>, StaticOrder, true, true>(lds, g, S, E);
#endif
    }
    xcd_barrier(xbar);
    mini_gateup(lds, RA + (size_t)NTOK_P * 1024, (const bf16*)(ws + WS_WGU), (const float*)(ws + WS_SS2) + (size_t)NTOK_P * 16, (bf16*)(ws + WS_H) + (size_t)NTOK_P * DFF);
    { Gemm g{RA, (const bf16_t*)(ws + WS_WGU), NTOK_P, 2 * DFF, 1024}; StaticOrder S; S.init(NTOK_P, 2 * DFF, G, c, P8_WGM); EpiGateUp E{(bf16_t*)(ws + WS_H), (const float*)(ws + WS_SS2)};
#ifndef NO_G8
      gemm_phase<EpiGateUp, StaticOrder, P8_ALIGN, P8_SP2>(lds, g, S, E);
#ifdef PROBE_G8X2
      __syncthreads(); gemm_phase<EpiGateUp, StaticOrder, true, true>(lds, g, S, E);
#endif
#endif
    }
    xcd_barrier(xbar);
    { MiniRes<false> ME{nullptr, P.out + (size_t)NTOK_P * 1024, nullptr, nullptr, nullptr, nullptr}; mini_gemm(lds, (const bf16*)(ws + WS_H) + (size_t)NTOK_P * DFF, (const bf16*)(ws + WS_WD), DFF, 1024, ME); }
    { Gemm g{(const bf16_t*)(ws + WS_H), (const bf16_t*)(ws + WS_WD), NTOK_P, 1024, DFF}; StaticOrder S; S.init(NTOK_P, 1024, G, c);
      if (G == 256) {
          pg8::EpiDownNorm E{P.out, P.in[I_GF], (float*)(ws + WS_XS), (unsigned*)(ws + WS_CTL) + 8192, (unsigned*)(ws + WS_CTL) + 8191, lds + 131072 + 2048};
          gemm_phase<pg8::EpiDownNorm, StaticOrder, true, true>(lds, g, S, E);
      } else {
          EpiRes<false> E{nullptr, nullptr, P.out, nullptr, nullptr, nullptr, nullptr};
          gemm_phase<EpiRes<false>, StaticOrder, true, true>(lds, g, S, E);
      }
    }
    xcd_barrier(xbar);
#ifndef NO_FN
    final_norm_phase(P, G == 256 ? NTOK_P : 0);
#endif
}

extern "C" void kernel_launch(void* const* d_in, const int* in_sizes, int n_in, void* d_out, int out_size, void* d_ws, size_t ws_size, hipStream_t stream) {
    static int grid = 0;
    if (grid == 0) {
        if (n_in != 22 || (size_t)out_size != O_END || ws_size < WS_END) { fprintf(stderr, "kernel_launch: unexpected problem: n_in %d out %d ws %zu (need %zu / %zu)\n", n_in, out_size, ws_size, (size_t)O_END, (size_t)WS_END); grid = -1; return; }
        int dev = 0, cus = 0, per_cu = 0;
        if (hipGetDevice(&dev) != hipSuccess || hipDeviceGetAttribute(&cus, hipDeviceAttributeMultiprocessorCount, dev) != hipSuccess) { fprintf(stderr, "kernel_launch: device query failed\n"); grid = -1; return; }
        if (hipFuncSetAttribute((const void*)mk_fwd, hipFuncAttributeMaxDynamicSharedMemorySize, LDS_BYTES) != hipSuccess) { fprintf(stderr, "kernel_launch: hipFuncSetAttribute failed\n"); grid = -1; return; }
        if (hipOccupancyMaxActiveBlocksPerMultiprocessor(&per_cu, (const void*)mk_fwd, NTHREADS, LDS_BYTES) != hipSuccess || per_cu < 1) { fprintf(stderr, "kernel_launch: occupancy query gave %d\n", per_cu); per_cu = 1; }
        (void)hipGetLastError();
        grid = cus * per_cu;
    }
    if (grid < 0) return;
    if (hipMemsetAsync((char*)d_ws + WS_CTL, 0, 131072, stream) != hipSuccess) { fprintf(stderr, "kernel_launch: hipMemsetAsync failed\n"); return; }
    Params p{};
    for (int i = 0; i < 22; ++i) p.in[i] = (const float*)d_in[i];
    p.out = (float*)d_out; p.ws = (unsigned char*)d_ws;
    void* args[] = {&p};
    hipError_t e = hipLaunchCooperativeKernel((const void*)mk_fwd, dim3(grid), dim3(NTHREADS), args, LDS_BYTES, stream);
    if (e != hipSuccess) fprintf(stderr, "kernel_launch: cooperative launch failed: %s (grid %d)\n", hipGetErrorString(e), grid);
}
```

```cpp
#include <hip/hip_runtime.h>
#include <hip/hip_cooperative_groups.h>
#include <cstdio>
#include <cstdint>
namespace cg = cooperative_groups;
namespace pg8 {
#define PG8_LAS __attribute__((address_space(3)))
typedef unsigned short bf16_t;
typedef short bf16x8 __attribute__((ext_vector_type(8)));
typedef float f32x4 __attribute__((ext_vector_type(4)));
typedef unsigned u32x4 __attribute__((ext_vector_type(4)));
constexpr int BM = 256, BK = 64, HALF = 128, HTB = HALF * BK * 2  , STAGE_BYTES = 8 * HTB, NXCD = 8, WGM = 8;

__host__ __device__ __forceinline__ int lds_byte(int r, int c) { const int st = (r >> 4) * 2 + (c >> 5), rr = r & 15, cc = c & 31, ob = rr * 64 + cc * 2; return st * 1024 + (ob ^ (((ob >> 9) & 1) << 5)); }
__host__ __device__ __forceinline__ void stage_rc(int b, int& R, int& C) { const int st = b / 1024, sb = b % 1024, swz = sb ^ (((sb >> 9) & 1) << 5); R = (st >> 1) * 16 + swz / 64; C = (st & 1) * 32 + (swz % 64) / 2; }
__host__ __device__ __forceinline__ int perm32(int rho) { const int n = rho >> 4, i = rho & 15; return 8 * (i >> 2) + 4 * n + (i & 3); }

struct Unit { int pm, pn; };
struct Gemm { const bf16_t* A; const bf16_t* Bt; int M, N, K; };

struct StaticOrder {
    int nM, nN, nwg, G, c, wgm;
    __host__ __device__ void init(int M, int N, int G_, int c_, int wgm_ = WGM) { nM = M / BM; nN = N / BM; nwg = nM * nN; G = G_; c = c_; wgm = wgm_; }
    __host__ __device__ bool next(int i, Unit& u) const {
        const long L = (long)i * G + c; if (L >= nwg) return false;
        int wgid = (int)L; { const int q = nwg / NXCD, r = nwg % NXCD, xcd = wgid % NXCD, off = wgid / NXCD; wgid = (xcd < r ? xcd * (q + 1) : r * (q + 1) + (xcd - r) * q) + off; }
        const int nig = wgm * nN, gid = wgid / nig, fm = gid * wgm, gsz = (nM - fm) < wgm ? (nM - fm) : wgm;
        u.pm = fm + ((wgid % nig) % gsz); u.pn = (wgid % nig) / gsz; return true;
    }
    __device__ __forceinline__ void a_ready(const Unit&) const {}
    __device__ __forceinline__ void done(const Unit&) const {}
};

__device__ __forceinline__ unsigned cvt_pk_bf16(float lo, float hi) { unsigned r; asm volatile("v_cvt_pk_bf16_f32 %0, %1, %2" : "=v"(r) : "v"(lo), "v"(hi)); return r; }
typedef float f32x2 __attribute__((ext_vector_type(2)));
typedef unsigned u32x2 __attribute__((ext_vector_type(2)));
struct EpiBf16 {
    static constexpr bool PERM = true, AFTER_DRAIN = false, MIDK = false;
    bf16_t* O; int ldc; float* ss;
    __device__ __forceinline__ void operator()(const f32x4 (&acc)[2][2][4][2], const Unit& u, int wr, int wc, int fr, int fq) const {
        int row0 = u.pm * BM + wr * 64 + fr; int col0 = u.pn * BM + wc * 32 + 8 * fq; asm volatile("" : "+v"(row0), "+v"(col0));
#pragma unroll
        for (int ai = 0; ai < 2; ++ai)
#pragma unroll
            for (int m = 0; m < 4; ++m) { bf16_t* rowp = O + (size_t)(row0 + ai * HALF + m * 16) * ldc + col0;
#pragma unroll
                for (int bj = 0; bj < 2; ++bj) { const f32x4 v0 = acc[ai][bj][m][0], v1 = acc[ai][bj][m][1];
                    u32x4 w; w.x = cvt_pk_bf16(v0[0], v0[1]); w.y = cvt_pk_bf16(v0[2], v0[3]); w.z = cvt_pk_bf16(v1[0], v1[1]); w.w = cvt_pk_bf16(v1[2], v1[3]);
                    *(u32x4*)(rowp + bj * HALF) = w; }
                if (ss) { float s = 0.f;
#pragma unroll
                    for (int bj = 0; bj < 2; ++bj)
#pragma unroll
                        for (int n = 0; n < 2; ++n) { const f32x4 v = acc[ai][bj][m][n]; s += (v[0] * v[0] + v[1] * v[1]) + (v[2] * v[2] + v[3] * v[3]); }
                    s += __shfl_xor(s, 16); s += __shfl_xor(s, 32);
                    if (fq == 0) ss[(size_t)(row0 + ai * HALF + m * 16) * 8 + u.pn * 4 + wc] = s; } }
    }
};
typedef _Float16 f16x2 __attribute__((ext_vector_type(2)));
struct EpiQRope {
    static constexpr bool PERM = true, AFTER_DRAIN = false, MIDK = false;
    bf16_t* O; const unsigned* tab16; float scale;
    __device__ __forceinline__ void operator()(const f32x4 (&acc)[2][2][4][2], const Unit& u, int wr, int wc, int fr, int fq) const {
        int row0 = u.pm * BM + wr * 64 + fr; int col0 = u.pn * BM + wc * 32 + 8 * fq; asm volatile("" : "+v"(row0), "+v"(col0));
#pragma unroll
        for (int bj = 0; bj < 2; ++bj) {
            const int c = col0 + bj * HALF; const int cm = c % 160; const bool rope = cm >= 128; const int ip = rope ? ((cm - 128) >> 1) : 0;
            u32x4 tw[8];
#pragma unroll
            for (int it = 0; it < 8; ++it) { const int row = row0 + (it >> 2) * HALF + (it & 3) * 16; const int pos = row < 65536 ? (row & 8191) : 4096 + ((row - 65536) & 31);
                tw[it] = *(const u32x4*)(tab16 + (size_t)pos * 16 + ip); }
#pragma unroll
            for (int it = 0; it < 8; ++it) {
                const int ai = it >> 2, m = it & 3;
                const int row = row0 + ai * HALF + m * 16;
                f32x4 v0 = acc[ai][bj][m][0], v1 = acc[ai][bj][m][1];
                float cs[4], sn[4];
#pragma unroll
                for (int k = 0; k < 4; ++k) { const unsigned wk = tw[it][k]; const f16x2 hv = __builtin_bit_cast(f16x2, wk);        cs[k] = rope ? (float)hv[0] : 1.0f; sn[k] = rope ? (float)hv[1] : 0.0f; }
                float a, b;
                a = v0[0]; b = v0[1]; v0[0] = a * cs[0] - b * sn[0]; v0[1] = b * cs[0] + a * sn[0];
                a = v0[2]; b = v0[3]; v0[2] = a * cs[1] - b * sn[1]; v0[3] = b * cs[1] + a * sn[1];
                a = v1[0]; b = v1[1]; v1[0] = a * cs[2] - b * sn[2]; v1[1] = b * cs[2] + a * sn[2];
                a = v1[2]; b = v1[3]; v1[2] = a * cs[3] - b * sn[3]; v1[3] = b * cs[3] + a * sn[3];
                v0 = v0 * scale; v1 = v1 * scale;
                u32x4 w; w.x = cvt_pk_bf16(v0[0], v0[1]); w.y = cvt_pk_bf16(v0[2], v0[3]); w.z = cvt_pk_bf16(v1[0], v1[1]); w.w = cvt_pk_bf16(v1[2], v1[3]);
                *(u32x4*)(O + (size_t)row * 1280 + c) = w;
            }
        }
    }
};
template <bool WO> struct EpiRes {
    static constexpr bool PERM = false, AFTER_DRAIN = false, MIDK = WO;
    const float* xp; const float* xs; float* out; bf16_t* xb; float* ss; const float* ratio; const float* rp;
    __device__ __forceinline__ void midk(f32x4 (&acc)[2][2][4][2], const Unit& u, int wr, int wc, int fr, int fq) const {
        int rowg = u.pm * BM + wr * 64 + fr; asm volatile("" : "+v"(rowg));
#pragma unroll
        for (int ai = 0; ai < 2; ++ai)
#pragma unroll
            for (int m = 0; m < 4; ++m) { const float rt = ratio[rowg + ai * HALF + m * 16];
#pragma unroll
                for (int bj = 0; bj < 2; ++bj)
#pragma unroll
                    for (int n = 0; n < 2; ++n) acc[ai][bj][m][n] = acc[ai][bj][m][n] * rt; }
    }
    __device__ __forceinline__ void operator()(const f32x4 (&acc)[2][2][4][2], const Unit& u, int wr, int wc, int fr, int fq) const {
        int rowl = wr * 64 + fr; int col0 = u.pn * BM + wc * 32 + 4 * fq; asm volatile("" : "+v"(rowl), "+v"(col0));
        float* dst = out + (size_t)u.pm * BM * 1024;
        const float* src = WO ? (u.pm < 256 ? xp + (size_t)u.pm * BM * 1024 : xs) : (const float*)dst;
        f32x4 cx[2][2]; float crp = 1.0f;
#pragma unroll
        for (int bj = 0; bj < 2; ++bj)
#pragma unroll
            for (int n = 0; n < 2; ++n) { const f32x4* sp_ = (const f32x4*)(src + (size_t)rowl * 1024 + col0 + bj * HALF + n * 16); cx[bj][n] = WO ? __builtin_nontemporal_load(sp_) : *sp_; }
        if (WO) crp = rp[(size_t)u.pm * BM + rowl];
#pragma unroll
        for (int it = 0; it < 8; ++it) {
            const int ai = it >> 2, m = it & 3;
            const int r = rowl + ai * HALF + m * 16; float s = 0.f;
            f32x4 nx[2][2]; float nrp = 1.0f;
            if (it < 7) { const int rn = rowl + ((it + 1) >> 2) * HALF + ((it + 1) & 3) * 16;
#pragma unroll
                for (int bj = 0; bj < 2; ++bj)
#pragma unroll
                    for (int n = 0; n < 2; ++n) { const f32x4* sp_ = (const f32x4*)(src + (size_t)rn * 1024 + col0 + bj * HALF + n * 16); nx[bj][n] = WO ? __builtin_nontemporal_load(sp_) : *sp_; }
                if (WO) nrp = rp[(size_t)u.pm * BM + rn]; }
#pragma unroll
            for (int bj = 0; bj < 2; ++bj)
#pragma unroll
                for (int n = 0; n < 2; ++n) {
                    const int c = col0 + bj * HALF + n * 16;
                    const f32x4 v = cx[bj][n] + (WO ? acc[ai][bj][m][n] * crp : acc[ai][bj][m][n]);
                    if (WO) __builtin_nontemporal_store(v, (f32x4*)(dst + (size_t)r * 1024 + c)); else *(f32x4*)(dst + (size_t)r * 1024 + c) = v;
                    s += (v[0] * v[0] + v[1] * v[1]) + (v[2] * v[2] + v[3] * v[3]);
                    if (WO) { u32x2 w; w.x = cvt_pk_bf16(v[0], v[1]); w.y = cvt_pk_bf16(v[2], v[3]); *(u32x2*)(xb + ((size_t)u.pm * BM + r) * 1024 + c) = w; }
                }
            if (WO) { s += __shfl_xor(s, 16); s += __shfl_xor(s, 32);
                if (fq == 0) ss[((size_t)u.pm * BM + r) * 16 + u.pn * 4 + wc] = s; }
            asm volatile("" ::: "memory");
            if (it < 7) {
#pragma unroll
                for (int bj = 0; bj < 2; ++bj)
#pragma unroll
                    for (int n = 0; n < 2; ++n) cx[bj][n] = nx[bj][n];
                crp = nrp; }
        }
    }
};
struct EpiGateUp {
    static constexpr bool PERM = true, AFTER_DRAIN = false, MIDK = false;
    bf16_t* H; const float* ss;
    __device__ __forceinline__ void operator()(const f32x4 (&acc)[2][2][4][2], const Unit& u, int wr, int wc, int fr, int fq) const {
        int row0 = u.pm * BM + wr * 64 + fr; int hc0 = u.pn * HALF + wc * 32 + 8 * fq; asm volatile("" : "+v"(row0), "+v"(hc0));
        f32x4 sl[8];
#pragma unroll
        for (int it = 0; it < 8; ++it) sl[it] = *(const f32x4*)(ss + (size_t)(row0 + (it >> 2) * HALF + (it & 3) * 16) * 16 + 4 * fq);
        float rr[8];
#pragma unroll
        for (int it = 0; it < 8; ++it) { float s = (sl[it][0] + sl[it][1]) + (sl[it][2] + sl[it][3]); s += __shfl_xor(s, 16); s += __shfl_xor(s, 32);
            rr[it] = __builtin_amdgcn_rsqf(s * (1.0f / 1024.0f) + 1e-6f); }
#pragma unroll
        for (int ai = 0; ai < 2; ++ai)
#pragma unroll
            for (int m = 0; m < 4; ++m) {
                const int row = row0 + ai * HALF + m * 16;
                const float r = rr[ai * 4 + m];
                f32x4 hv[2];
#pragma unroll
                for (int n = 0; n < 2; ++n) {
                    const f32x4 g = acc[ai][0][m][n] * r, up = acc[ai][1][m][n] * r;
#pragma unroll
                    for (int e2 = 0; e2 < 4; ++e2) { const float sg = __builtin_amdgcn_rcpf(1.0f + __builtin_amdgcn_exp2f(-1.4426950408889634f * g[e2])); hv[n][e2] = g[e2] * sg * up[e2]; }
                }
                u32x4 w; w.x = cvt_pk_bf16(hv[0][0], hv[0][1]); w.y = cvt_pk_bf16(hv[0][2], hv[0][3]); w.z = cvt_pk_bf16(hv[1][0], hv[1][1]); w.w = cvt_pk_bf16(hv[1][2], hv[1][3]);
                __builtin_nontemporal_store(w, (u32x4*)(H + (size_t)row * 2816 + hc0));
            }
    }
};
struct EpiDownNorm {
    static constexpr bool PERM = false, AFTER_DRAIN = false, MIDK = false;
    float* out; const float* g; float* xs; unsigned* cnt; unsigned* tmo; PG8_LAS unsigned char* sl;
    __device__ __forceinline__ void operator()(f32x4 (&acc)[2][2][4][2], const Unit& u, int wr, int wc, int fr, int fq) const {
        int rowl = wr * 64 + fr; int col0 = u.pn * BM + wc * 32 + 4 * fq; asm volatile("" : "+v"(rowl), "+v"(col0));
        float* dst = out + (size_t)u.pm * BM * 1024;
        PG8_LAS float* Pt = (PG8_LAS float*)sl;
        PG8_LAS float* St = (PG8_LAS float*)(sl + 4096);
        PG8_LAS unsigned* flag = (PG8_LAS unsigned*)(sl + 5120);
        const int tid = threadIdx.x, lane = tid & 63, wid = tid >> 6;
#pragma unroll
        for (int ai = 0; ai < 2; ++ai)
#pragma unroll
            for (int m = 0; m < 4; ++m) {
                const int r = rowl + ai * HALF + m * 16; float s = 0.f;
#pragma unroll
                for (int bj = 0; bj < 2; ++bj)
#pragma unroll
                    for (int n = 0; n < 2; ++n) { const f32x4 v = *(const f32x4*)(dst + (size_t)r * 1024 + col0 + bj * HALF + n * 16) + acc[ai][bj][m][n]; acc[ai][bj][m][n] = v;
                        s += (v[0] * v[0] + v[1] * v[1]) + (v[2] * v[2] + v[3] * v[3]); }
                s += __shfl_xor(s, 16); s += __shfl_xor(s, 32);
                if (fq == 0) Pt[r * 4 + wc] = s;
                if (m & 1) asm volatile("" ::: "memory");
            }
        asm volatile("s_waitcnt lgkmcnt(0)\n\ts_barrier" ::: "memory");
        if (tid < 256) {
            const f32x4 p = *(const PG8_LAS f32x4*)(Pt + tid * 4);
            __hip_atomic_store(xs + ((size_t)u.pm * BM + tid) * 4 + u.pn, (p[0] + p[1]) + (p[2] + p[3]), __ATOMIC_RELAXED, __HIP_MEMORY_SCOPE_AGENT);
            asm volatile("s_waitcnt vmcnt(0)" ::: "memory");
            if (lane == 0) __hip_atomic_fetch_add(cnt + 64 * u.pm, 1u, __ATOMIC_RELAXED, __HIP_MEMORY_SCOPE_AGENT);
        }
        if (wid == 0) {
            unsigned sp = 0; bool dead = false;
            while ((unsigned)__builtin_amdgcn_readfirstlane(__hip_atomic_load(cnt + 64 * u.pm, __ATOMIC_RELAXED, __HIP_MEMORY_SCOPE_AGENT)) < 16u) {
                __builtin_amdgcn_s_sleep(2);
                if (++sp > (1u << 22)) { dead = true; break; }
            }
            __builtin_amdgcn_fence(__ATOMIC_ACQUIRE, "agent");
            if (lane == 0) { flag[0] = dead ? 1u : 0u; if (dead) __hip_atomic_store(tmo, 1u, __ATOMIC_RELAXED, __HIP_MEMORY_SCOPE_AGENT); }
        }
        asm volatile("s_waitcnt vmcnt(0) lgkmcnt(0)\n\ts_barrier" ::: "memory");
        if (tid < 256) {
            const float* sp4 = xs + ((size_t)u.pm * BM + tid) * 4; float t = 0.f;
#pragma unroll
            for (int k = 0; k < 4; ++k) t += __hip_atomic_load(sp4 + k, __ATOMIC_RELAXED, __HIP_MEMORY_SCOPE_AGENT);
            St[tid] = __builtin_amdgcn_rsqf(t * (1.0f / 1024.0f) + 1e-6f);
        }
        asm volatile("s_waitcnt lgkmcnt(0)\n\ts_barrier" ::: "memory");
        f32x4 gv[2][2];
#pragma unroll
        for (int bj = 0; bj < 2; ++bj)
#pragma unroll
            for (int n = 0; n < 2; ++n) gv[bj][n] = *(const f32x4*)(g + col0 + bj * HALF + n * 16);
#pragma unroll
        for (int ai = 0; ai < 2; ++ai)
#pragma unroll
            for (int m = 0; m < 4; ++m) {
                const int r = rowl + ai * HALF + m * 16; const float rs = St[r];
#pragma unroll
                for (int bj = 0; bj < 2; ++bj)
#pragma unroll
                    for (int n = 0; n < 2; ++n) __builtin_nontemporal_store(acc[ai][bj][m][n] * rs * gv[bj][n], (f32x4*)(dst + (size_t)r * 1024 + col0 + bj * HALF + n * 16));
            }
        asm volatile("s_waitcnt lgkmcnt(0)\n\ts_barrier" ::: "memory");
    }
};
template <class Epi, class Sched, bool ALIGN_EPI = false, bool SP2 = false>
__device__ __forceinline__ void gemm_phase(PG8_LAS unsigned char* lds, const Gemm g, const Sched& S, const Epi& E) {
    int tid_l = threadIdx.x; asm volatile("" : "+v"(tid_l)); const int tid = tid_l, wid = __builtin_amdgcn_readfirstlane(tid >> 6), lane = tid & 63, wr = wid >> 2, wc = wid & 3, fr = lane & 15, fq = lane >> 4;
    int K_l = g.K; asm volatile("" : "+s"(K_l)); const int K = K_l, nt = K / BK;
    unsigned voffA[2], voffB[2];
#pragma unroll
    for (int i = 0; i < 2; ++i) { int R, C; stage_rc(tid * 16 + i * 8192, R, C); const int Rb = Epi::PERM ? ((R & ~31) + perm32(R & 31)) : R;
        voffA[i] = (unsigned)(R * K + C) * 2u; voffB[i] = (unsigned)(Rb * K + C) * 2u; }
    const size_t kstep = (size_t)(BK * 2);
    const size_t hstep = (size_t)HALF * K * 2;
    const size_t tstep = 2 * hstep;
    const unsigned ldsw = (unsigned)wid * 1024u;
    const int aoff = lds_byte(wr * 64 + fr, fq * 8), boff = lds_byte(wc * 32 + fr, fq * 8);
#define PG8_SA(b, h) (((b) * 2 + (h)) * HTB)
#define PG8_SB(b, h) ((4 + (b) * 2 + (h)) * HTB)
#define PG8_STAGE(bufoff, gbase, voff) do { _Pragma("unroll") for (int _i = 0; _i < 2; ++_i) \
        __builtin_amdgcn_global_load_lds((const unsigned*)((const char*)(gbase) + (voff)[_i]), (PG8_LAS unsigned*)(lds + (bufoff) + ldsw + _i * 8192), 16, 0, 0); } while (0)
#define PG8_LDA(dst, b, h) do { _Pragma("unroll") for (int m = 0; m < 4; ++m) _Pragma("unroll") for (int k = 0; k < 2; ++k) dst[m][k] = *(const PG8_LAS bf16x8*)(lds + PG8_SA(b, h) + aoff + m * 2048 + k * 1024); } while (0)
#define PG8_LDB(dst, b, h) do { _Pragma("unroll") for (int n = 0; n < 2; ++n) _Pragma("unroll") for (int k = 0; k < 2; ++k) dst[n][k] = *(const PG8_LAS bf16x8*)(lds + PG8_SB(b, h) + boff + n * 2048 + k * 1024); } while (0)
#define PG8_MMA(ai, bj, At, Bt) do { __builtin_amdgcn_s_setprio(1); _Pragma("unroll") for (int m = 0; m < 4; ++m) _Pragma("unroll") for (int n = 0; n < 2; ++n) _Pragma("unroll") for (int k = 0; k < 2; ++k) \
        acc[ai][bj][m][n] = __builtin_amdgcn_mfma_f32_16x16x32_bf16(Bt[n][k], At[m][k], acc[ai][bj][m][n], 0, 0, 0); __builtin_amdgcn_s_setprio(0); } while (0)
#define PG8_WAIT_V(n) asm volatile("s_waitcnt vmcnt(" #n ")" ::: "memory")
#define PG8_WAIT_L(n) asm volatile("s_waitcnt lgkmcnt(" #n ")" ::: "memory")
#define PG8_BAR __builtin_amdgcn_s_barrier()
#define PG8_SCHED __builtin_amdgcn_sched_barrier(0)
    Unit cur, nxt; int ui = 0;
    if (!S.next(0, cur)) return;
    f32x4 acc[2][2][4][2];
#pragma unroll
    for (int a = 0; a < 2; ++a)
#pragma unroll
        for (int b = 0; b < 2; ++b)
#pragma unroll
            for (int m = 0; m < 4; ++m)
#pragma unroll
                for (int n = 0; n < 2; ++n) acc[a][b][m][n] = (f32x4){0.f, 0.f, 0.f, 0.f};
    bf16x8 At[4][2], B0[2][2], B1[2][2];
    const char* cA = (const char*)g.A + (size_t)cur.pm * tstep; const char* cB = (const char*)g.Bt + (size_t)cur.pn * tstep;
    S.a_ready(cur);
    if constexpr (SP2) {
        PG8_STAGE(PG8_SB(0, 0), cB, voffB); PG8_STAGE(PG8_SB(0, 1), cB + hstep, voffB); PG8_STAGE(PG8_SA(0, 0), cA, voffA); PG8_STAGE(PG8_SA(0, 1), cA + hstep, voffA);
        if (wr == 1) PG8_BAR;
        PG8_WAIT_V(2); PG8_BAR;
        PG8_STAGE(PG8_SB(1, 0), cB + kstep, voffB); PG8_STAGE(PG8_SA(1, 0), cA + kstep, voffA); PG8_STAGE(PG8_SB(1, 1), cB + hstep + kstep, voffB);
        PG8_WAIT_V(6); PG8_BAR;
    } else {
        PG8_STAGE(PG8_SB(0, 0), cB, voffB); PG8_STAGE(PG8_SA(0, 0), cA, voffA); PG8_STAGE(PG8_SB(0, 1), cB + hstep, voffB); PG8_STAGE(PG8_SA(0, 1), cA + hstep, voffA);
        if (wr == 1) PG8_BAR;
        PG8_WAIT_V(4); PG8_BAR;
        PG8_STAGE(PG8_SB(1, 0), cB + kstep, voffB); PG8_STAGE(PG8_SA(1, 0), cA + kstep, voffA); PG8_STAGE(PG8_SB(1, 1), cB + hstep + kstep, voffB);
        PG8_WAIT_V(6); PG8_BAR;
    }
    for (;;) {
        const bool has_next = S.next(ui + 1, nxt);
        const char* nA = has_next ? (const char*)g.A + (size_t)nxt.pm * tstep : cA; const char* nB = has_next ? (const char*)g.Bt + (size_t)nxt.pn * tstep : cB;
        for (int t = 0; t < nt; t += 2) {
            const bool last = (t == nt - 2);
            const char* a1 = cA + (size_t)(t + 1) * kstep;
            const char* a2 = last ? nA : cA + (size_t)(t + 2) * kstep; const char* b2 = last ? nB : cB + (size_t)(t + 2) * kstep;
            const char* a3 = a2 + kstep; const char* b3 = b2 + kstep;
            if (last && has_next) S.a_ready(nxt);
            if constexpr (Epi::MIDK) { if (t == nt / 2) E.midk(acc, cur, wr, wc, fr, fq); }
            if constexpr (SP2) {
            PG8_LDB(B0, 0, 0); PG8_LDB(B1, 0, 1); PG8_SCHED; PG8_LDA(At, 0, 0); PG8_STAGE(PG8_SA(1, 1), a1 + hstep, voffA);
            PG8_WAIT_V(8); PG8_WAIT_L(0); PG8_BAR; PG8_MMA(0, 0, At, B0); PG8_MMA(0, 1, At, B1); PG8_BAR; PG8_SCHED;
            PG8_LDA(At, 0, 1); PG8_STAGE(PG8_SB(0, 0), b2, voffB); PG8_STAGE(PG8_SB(0, 1), b2 + hstep, voffB); PG8_STAGE(PG8_SA(0, 0), a2, voffA);
            PG8_WAIT_V(8); PG8_WAIT_L(0); PG8_BAR; PG8_MMA(1, 0, At, B0); PG8_MMA(1, 1, At, B1); PG8_BAR; PG8_SCHED;
            PG8_LDB(B0, 1, 0); PG8_LDB(B1, 1, 1); PG8_SCHED; PG8_LDA(At, 1, 0); PG8_STAGE(PG8_SA(0, 1), a2 + hstep, voffA);
            PG8_WAIT_V(8); PG8_WAIT_L(0); PG8_BAR; PG8_MMA(0, 0, At, B0); PG8_MMA(0, 1, At, B1); PG8_BAR; PG8_SCHED;
            PG8_LDA(At, 1, 1); PG8_STAGE(PG8_SB(1, 0), b3, voffB); PG8_STAGE(PG8_SB(1, 1), b3 + hstep, voffB); PG8_STAGE(PG8_SA(1, 0), a3, voffA);
            PG8_WAIT_V(8); PG8_WAIT_L(0); PG8_BAR; PG8_MMA(1, 0, At, B0); PG8_MMA(1, 1, At, B1); PG8_BAR; PG8_SCHED;
            } else {
            PG8_LDB(B0, 0, 0); PG8_SCHED; PG8_LDA(At, 0, 0); PG8_STAGE(PG8_SA(1, 1), a1 + hstep, voffA);
            PG8_WAIT_L(8); PG8_BAR; PG8_WAIT_L(0); PG8_MMA(0, 0, At, B0); PG8_BAR; PG8_SCHED;
            PG8_LDB(B1, 0, 1); PG8_STAGE(PG8_SB(0, 0), b2, voffB);
            PG8_BAR; PG8_WAIT_L(0); PG8_MMA(0, 1, At, B1); PG8_BAR;
            PG8_LDA(At, 0, 1); PG8_STAGE(PG8_SA(0, 0), a2, voffA);
            PG8_BAR; PG8_WAIT_L(0); PG8_MMA(1, 0, At, B0); PG8_BAR; PG8_SCHED;
            PG8_STAGE(PG8_SB(0, 1), b2 + hstep, voffB);
            PG8_WAIT_V(6); PG8_BAR; PG8_MMA(1, 1, At, B1); PG8_BAR;
            PG8_LDB(B0, 1, 0); PG8_SCHED; PG8_LDA(At, 1, 0); PG8_STAGE(PG8_SA(0, 1), a2 + hstep, voffA);
            PG8_WAIT_L(8); PG8_BAR; PG8_WAIT_L(0); PG8_MMA(0, 0, At, B0); PG8_BAR; PG8_SCHED;
            PG8_LDB(B1, 1, 1); PG8_STAGE(PG8_SB(1, 0), b3, voffB);
            PG8_BAR; PG8_WAIT_L(0); PG8_MMA(0, 1, At, B1); PG8_BAR;
            PG8_LDA(At, 1, 1); PG8_STAGE(PG8_SA(1, 0), a3, voffA);
            PG8_BAR; PG8_WAIT_L(0); PG8_MMA(1, 0, At, B0); PG8_BAR; PG8_SCHED;
            PG8_STAGE(PG8_SB(1, 1), b3 + hstep, voffB);
            PG8_WAIT_V(6); PG8_BAR; PG8_MMA(1, 1, At, B1); PG8_BAR;
            }
        }
        if constexpr (ALIGN_EPI) { if (wr == 0) PG8_BAR; }
        if constexpr (!Epi::AFTER_DRAIN) { E(acc, cur, wr, wc, fr, fq); S.done(cur); }
        if (!has_next) break;
#pragma unroll
        for (int a = 0; a < 2; ++a)
#pragma unroll
            for (int b = 0; b < 2; ++b)
#pragma unroll
                for (int m = 0; m < 4; ++m)
#pragma unroll
                    for (int n = 0; n < 2; ++n) acc[a][b][m][n] = (f32x4){0.f, 0.f, 0.f, 0.f};
        cur = nxt; cA = nA; cB = nB; ++ui;
        if constexpr (ALIGN_EPI) { if (wr == 1) PG8_BAR; }
    }
    PG8_WAIT_V(0);
    if constexpr (!ALIGN_EPI) { if (wr == 0) PG8_BAR; }
    PG8_BAR;
    if constexpr (Epi::AFTER_DRAIN) { E.fused(acc, cur, wr, wc, fr, fq, lds, wid, lane); S.done(cur); }
#undef PG8_SA
#undef PG8_SB
#undef PG8_STAGE
#undef PG8_LDA
#undef PG8_LDB
#undef PG8_MMA
#undef PG8_WAIT_V
#undef PG8_WAIT_L
#undef PG8_BAR
#undef PG8_SCHED
}
}
#define LAS __attribute__((address_space(3)))
typedef unsigned short bf16;
typedef unsigned u32x4 __attribute__((ext_vector_type(4)));
typedef unsigned u32x2 __attribute__((ext_vector_type(2)));
typedef float f32x4 __attribute__((ext_vector_type(4)));
typedef float f32x16 __attribute__((ext_vector_type(16)));
typedef short bf16x8 __attribute__((ext_vector_type(8)));
typedef short s16x4 __attribute__((ext_vector_type(4)));
typedef short v4i16_t __attribute__((ext_vector_type(4)));

constexpr int NTOK_P = 65536, NTOK_S = 256, NT = NTOK_P + NTOK_S;
constexpr int DM = 1024, DFF = 2816, INW = 928;
constexpr float EPS = 1e-6f;
constexpr float QSCALE = 0.10206207261596575f * 1.4426950408889634f;
constexpr int SKV = 4160;

constexpr size_t MiB = 1u << 20;
constexpr size_t WS_CTL = 0, WS_TAB = 1 * MiB, WS_WIN = 2 * MiB, WS_WO = 4 * MiB, WS_WQ = 6 * MiB, WS_WUV = 7 * MiB, WS_WPOOL = 8 * MiB, WS_TAB16 = 8 * MiB + 512 * 1024, WS_WD = 9 * MiB, WS_WGU = 15 * MiB;
constexpr size_t WS_SS2 = 26 * MiB, WS_SSP = 31 * MiB, WS_XS = 26 * MiB, WS_RP = 34 * MiB, WS_RATIO = 35 * MiB;
constexpr size_t WS_A = 36 * MiB;
constexpr size_t WS_B = 165 * MiB;
constexpr size_t WS_CQ = 294 * MiB, WS_KLP = 327 * MiB, WS_KLS = 348 * MiB, WS_VTP = 359 * MiB, WS_VTS = 377 * MiB, WS_POOLED = 387 * MiB, WS_QL = 452 * MiB;
constexpr size_t WS_H = 165 * MiB;
constexpr size_t WS_END = 613 * MiB;
static_assert(WS_KLP + (size_t)NTOK_P * 336 <= WS_KLS && WS_KLS + (size_t)8 * SKV * 336 <= WS_VTP && WS_VTP + (size_t)1024 * 18432 <= WS_VTS && WS_VTS + (size_t)8 * 65 * 18432 <= WS_POOLED && WS_POOLED + (size_t)NT * 1024 <= WS_QL, "ws map");
static_assert(WS_H + (size_t)NT * DFF * 2 <= WS_END, "H overlay");
static_assert(WS_QL + (size_t)NT * 1280 * 2 <= WS_END, "QL");

constexpr size_t O_Y = 0, O_KVP = (size_t)NT * DM, O_KRP = O_KVP + (size_t)NTOK_P * 128, O_POOLP = O_KRP + (size_t)NTOK_P * 32, O_KVS = O_POOLP + 8 * 15 * 512,
                 O_KRS = O_KVS + (size_t)NTOK_S * 128, O_POOLS = O_KRS + (size_t)NTOK_S * 32, O_END = O_POOLS + 8 * 15 * 512;

constexpr int LDS_BYTES = 131072 + 2048 + 6144;
constexpr int NTHREADS = 512;
#ifndef P8_ALIGN
#define P8_ALIGN true
#endif
#ifndef P8_SP2
#define P8_SP2 true
#endif
#ifndef P8_WGM
#define P8_WGM 8
#endif

#define LDS_WAIT() asm volatile("s_waitcnt lgkmcnt(0)" ::: "memory")
typedef float f32x2_t __attribute__((ext_vector_type(2))); typedef __bf16 bf16x2_t __attribute__((ext_vector_type(2)));
__device__ __forceinline__ unsigned pk2(float lo, float hi) { return pg8::cvt_pk_bf16(lo, hi); }
__device__ __forceinline__ unsigned pk2v(float lo, float hi) { f32x2_t v = {lo, hi}; bf16x2_t b = __builtin_convertvector(v, bf16x2_t); return __builtin_bit_cast(unsigned, b); }
__device__ __forceinline__ float bflo(unsigned u) { return __builtin_bit_cast(float, u << 16); }
__device__ __forceinline__ float bfhi(unsigned u) { return __builtin_bit_cast(float, u & 0xffff0000u); }
__device__ __forceinline__ float wave_sum(float v) {
#pragma unroll
    for (int o = 1; o < 64; o <<= 1) v += __shfl_xor(v, o);
    return v;
}

struct Params { const float* in[22]; float* out; unsigned char* ws; };
enum { I_XP = 0, I_XS, I_CKV, I_CKR, I_SPOOL, I_GN1, I_WIN, I_GQ, I_WUQ, I_GKV, I_WUK, I_WUV, I_WPOOL, I_PSCALE, I_GOA, I_GOP, I_WO, I_GN2, I_WG, I_WU, I_WD, I_GF };

template <bool KPERM = false>
__device__ __forceinline__ void tr_item(const float* W, int ldw, const float* kscale, const float* nscale, bf16* WT, int ldt, int drow0, int dcol0, LAS float* scr, int lane) {
    f32x4 wv[8];
#pragma unroll
    for (int i = 0; i < 8; ++i) wv[i] = *(const f32x4*)(W + (size_t)(8 * i + (lane >> 3)) * ldw + 4 * (lane & 7));
    f32x4 nsc = {1.f, 1.f, 1.f, 1.f}; if (nscale) nsc = *(const f32x4*)(nscale + 4 * (lane & 7));
#pragma unroll
    for (int i = 0; i < 8; ++i) { const int kk = 8 * i + (lane >> 3); f32x4 v = wv[i] * nsc; if (kscale) v = v * kscale[kk];
        LAS float* d = scr + kk * 33 + 4 * (lane & 7); d[0] = v[0]; d[1] = v[1]; d[2] = v[2]; d[3] = v[3]; }
    LDS_WAIT(); asm volatile("" ::: "memory");
    const int c = lane & 7;
#pragma unroll
    for (int j = 0; j < 4; ++j) { const int n = (lane >> 3) + 8 * j; const LAS float* s = scr + (KPERM ? ((8 * c) & ~15) + 4 * (c & 1) : 8 * c) * 33 + n; constexpr int HS = KPERM ? 8 : 4;
        u32x4 o; o.x = pk2(s[0 * 33], s[1 * 33]); o.y = pk2(s[2 * 33], s[3 * 33]); o.z = pk2(s[HS * 33], s[(HS + 1) * 33]); o.w = pk2(s[(HS + 2) * 33], s[(HS + 3) * 33]);
        *(u32x4*)(WT + (size_t)(drow0 + n) * ldt + dcol0 + 8 * c) = o; }
    LDS_WAIT(); asm volatile("" ::: "memory");
}

__device__ __forceinline__ void p0_prologue(const Params& P, LAS unsigned char* lds) {
    int tid_l = threadIdx.x; asm volatile("" : "+v"(tid_l)); const int tid = tid_l, lane = tid & 63, wave = tid >> 6;
    unsigned char* ws = P.ws;
    LAS float* scr = (LAS float*)(lds + wave * 16384);
    const int gw = blockIdx.x * 8 + wave, NGW = gridDim.x * 8;
    const int gt = blockIdx.x * NTHREADS + tid, GT = gridDim.x * NTHREADS;
    bf16* WinT = (bf16*)(ws + WS_WIN); bf16* WoT = (bf16*)(ws + WS_WO); bf16* WqT = (bf16*)(ws + WS_WQ); bf16* WuvT = (bf16*)(ws + WS_WUV);
    bf16* WpoolT = (bf16*)(ws + WS_WPOOL); bf16* WdT = (bf16*)(ws + WS_WD); bf16* WguT = (bf16*)(ws + WS_WGU);
    bf16* KLs = (bf16*)(ws + WS_KLS);
    constexpr int N_WIN = 16 * 29, N_WO = 16 * 32, N_WD = 44 * 32, N_WG = 16 * 88, N_WPOOL = 32;
    constexpr int NITEMS = N_WIN + N_WO + N_WD + 2 * N_WG + N_WPOOL;
    for (int it = gw; it < NITEMS; it += NGW) {
        int r = it;
        if (r < N_WIN) { const int kb = r / 29, nb = r % 29; tr_item(P.in[I_WIN] + (size_t)(64 * kb) * INW + 32 * nb, INW, nullptr, nullptr, WinT, 1024, 32 * nb, 64 * kb, scr, lane); continue; } r -= N_WIN;
        if (r < N_WO) { const int kb = r / 32, nb = r % 32; tr_item(P.in[I_WO] + (size_t)(64 * kb) * 1024 + 32 * nb, 1024, kb < 8 ? P.in[I_GOA] + 64 * kb : P.in[I_GOP] + 64 * (kb - 8), nullptr, WoT, 1024, 32 * nb, 64 * kb, scr, lane); continue; } r -= N_WO;
        if (r < N_WD) { const int kb = r / 32, nb = r % 32; tr_item(P.in[I_WD] + (size_t)(64 * kb) * 1024 + 32 * nb, 1024, nullptr, nullptr, WdT, DFF, 32 * nb, 64 * kb, scr, lane); continue; } r -= N_WD;
        if (r < 2 * N_WG) { const int up = r >= N_WG; if (up) r -= N_WG; const int kb = r / 88, nb = r % 88; const int n0 = 32 * nb;
            tr_item(P.in[up ? I_WU : I_WG] + (size_t)(64 * kb) * DFF + n0, DFF, P.in[I_GN2] + 64 * kb, nullptr, WguT, 1024, 256 * (n0 >> 7) + (n0 & 127) + (up ? 128 : 0), 64 * kb, scr, lane); continue; } r -= 2 * N_WG;
        if (r < N_WPOOL) { const int g = r >> 3, kb = (r >> 2) & 1, nb = r & 3;
            tr_item(P.in[I_WPOOL] + (size_t)g * 16384 + (size_t)(64 * kb) * 128 + 32 * nb, 128, nullptr, P.in[I_PSCALE] + 128 * g + 32 * nb, WpoolT, 512, 128 * g + 32 * nb, 128 * g + 64 * kb, scr, lane); continue; } r -= N_WPOOL;
    }
    const u32x4 z4 = {0u, 0u, 0u, 0u};
    for (int i = gt; i < 96 * 128; i += GT) ((u32x4*)(WinT + (size_t)928 * 1024))[i] = z4;
    for (int i = gt; i < 512 * 64; i += GT) { const int n = i >> 6, c8 = i & 63; if ((n >> 7) != (c8 >> 4)) ((u32x4*)WpoolT)[i] = z4; }
    for (int i = gt; i < 65536; i += GT) { const int j = i & 7, ln = (i >> 3) & 63, s2 = (i >> 9) & 1, db = (i >> 10) & 3, ddb = (i >> 12) & 1, hd = i >> 13;
        const int dd = 32 * ddb + (ln & 31), r = 32 * db + 16 * s2 + 8 * (j >> 2) + 4 * (ln >> 5) + (j & 3);
        WuvT[i] = (bf16)(pk2(P.in[I_WUV][((size_t)hd * 128 + r) * 64 + dd], 0.f) & 0xffffu); }
    for (int i = gt; i < 8 * 128 * 256; i += GT) {
        const int k = i & 255, r = (i >> 8) & 127, h = i >> 15;
        const f32x4* a = (const f32x4*)(P.in[I_WUQ] + (size_t)k * 768 + h * 96); const f32x4* b = (const f32x4*)(P.in[I_WUK] + ((size_t)h * 128 + r) * 64);
        float s = 0.f;
#pragma unroll 16
        for (int d = 0; d < 16; ++d) { const f32x4 x = a[d], y = b[d]; s += (x[0] * y[0] + x[1] * y[1]) + (x[2] * y[2] + x[3] * y[3]); }
        WqT[(size_t)(160 * h + r) * 256 + k] = (bf16)(pk2(s, 0.f) & 0xffffu);
    }
    for (int i = gt; i < 8 * 32 * 256; i += GT) {
        const int k = i & 255, ii = (i >> 8) & 31, h = i >> 13;
        const int prow = 160 * h + 128 + (ii < 16 ? 2 * ii : 2 * (ii - 16) + 1);
        WqT[(size_t)prow * 256 + k] = (bf16)(pk2(P.in[I_WUQ][(size_t)k * 768 + h * 96 + 64 + ii], 0.f) & 0xffffu);
    }
    {
        float* tab = (float*)(ws + WS_TAB);
        for (int i = gt; i < 8192 * 16; i += GT) {
            const int pos = i >> 4, f = i & 15;
            const int fl = f & 3, fh = f >> 2;
            double fr = fl == 0 ? 1.0 : (fl == 1 ? 0.5623413251903491 : (fl == 2 ? 0.31622776601683794 : 0.17782794100389228));
            fr *= fh == 0 ? 1.0 : (fh == 1 ? 0.1 : (fh == 2 ? 0.01 : 0.001));
            const double rev = (double)pos * fr * 0.15915494309189535;
            const float frac = (float)(rev - __builtin_rint(rev));
            const float cv_ = __builtin_amdgcn_cosf(frac), sv_ = __builtin_amdgcn_sinf(frac);
            tab[2 * i] = cv_; tab[2 * i + 1] = sv_;
            { typedef _Float16 h2_t __attribute__((ext_vector_type(2))); const h2_t hv_ = {(_Float16)cv_, (_Float16)sv_}; ((unsigned*)(ws + WS_TAB16))[i] = __builtin_bit_cast(unsigned, hv_); }
        }
    }
    if (gt < 64) ((unsigned*)(ws + WS_CTL))[gt] = 0u;
    {
        bf16* XN = (bf16*)(ws + WS_A);
        const f32x4* g4 = (const f32x4*)P.in[I_GN1] + lane;
        f32x4 gg[4];
#pragma unroll
        for (int j = 0; j < 4; ++j) gg[j] = g4[64 * j];
        for (int row0 = gw; row0 < NT; row0 += 4 * NGW) {
            f32x4 v[4][4]; int rows[4];
#pragma unroll
            for (int k = 0; k < 4; ++k) { const int row = row0 + k * NGW < NT ? row0 + k * NGW : row0; rows[k] = row;
                const float* xa = row < NTOK_P ? P.in[I_XP] + (size_t)row * DM : P.in[I_XS] + (size_t)(row - NTOK_P) * DM; const f32x4* xr = (const f32x4*)xa + lane;
#pragma unroll
                for (int j = 0; j < 4; ++j) v[k][j] = __builtin_nontemporal_load(xr + 64 * j); }
#pragma unroll
            for (int k = 0; k < 4; ++k) {
                float s = 0.f;
#pragma unroll
                for (int j = 0; j < 4; ++j) s += (v[k][j][0] * v[k][j][0] + v[k][j][1] * v[k][j][1]) + (v[k][j][2] * v[k][j][2] + v[k][j][3] * v[k][j][3]);
                const float rstd = __builtin_amdgcn_rsqf(wave_sum(s) * (1.0f / DM) + EPS);
                u32x2* o = (u32x2*)(XN + (size_t)rows[k] * DM) + lane;
#pragma unroll
                for (int j = 0; j < 4; ++j) { const f32x4 g = gg[j]; u32x2 w; w.x = pk2(v[k][j][0] * rstd * g[0], v[k][j][1] * rstd * g[1]); w.y = pk2(v[k][j][2] * rstd * g[2], v[k][j][3] * rstd * g[3]); o[64 * j] = w; }
            }
        }
    }
    for (int r0 = gw; r0 < 8 * 4096; r0 += 4 * NGW) {
        float2 v[4]; float k1[4], k2[4]; int rr[4];
#pragma unroll
        for (int k = 0; k < 4; ++k) { const int r = r0 + k * NGW < 8 * 4096 ? r0 + k * NGW : r0; rr[k] = r;
            v[k] = *(const float2*)(P.in[I_CKV] + (size_t)r * 128 + 2 * lane); const float* kr = P.in[I_CKR] + (size_t)r * 32; k1[k] = kr[lane & 15]; k2[k] = kr[16 + (lane & 15)]; }
#pragma unroll
        for (int k = 0; k < 4; ++k) { const int b = rr[k] >> 12, j = rr[k] & 4095;
            unsigned* dst = (unsigned*)(KLs + ((size_t)b * SKV + j) * 160); const int sg = (j >> 2) & 3;
            dst[(((lane >> 2) ^ sg) << 2) + (lane & 3)] = pk2(v[k].x, v[k].y);
            if (lane < 16) dst[64 + (((lane >> 2) ^ sg) << 2) + (lane & 3)] = pk2(k1[k], k2[k]); }
    }
}

__device__ __forceinline__ void p2_phase(const Params& P, LAS unsigned char* lds) {
    int tid_l = threadIdx.x; asm volatile("" : "+v"(tid_l)); const int tid = tid_l, lane = tid & 63, wave = tid >> 6;
    unsigned char* ws = P.ws;
    const bf16* Z = (const bf16*)(ws + WS_B);
    bf16* CQ = (bf16*)(ws + WS_CQ); bf16* KLp = (bf16*)(ws + WS_KLP); bf16* KLs = (bf16*)(ws + WS_KLS);
    bf16* POOLED = (bf16*)(ws + WS_POOLED);
    const float* tab = (const float*)(ws + WS_TAB);
    float* out = P.out;
    LAS unsigned char* U = lds + 16384;
    constexpr int UROW = 1040;
    const int grp = lane >> 4, wwin = 2 << grp;
    const u32x4 z4 = {0u, 0u, 0u, 0u};
    const f32x4 gq = *((const f32x4*)P.in[I_GQ] + lane);
    const float2 gkv = *((const float2*)P.in[I_GKV] + lane);
    for (int unit = blockIdx.x; unit < NT / 64; unit += gridDim.x) {
        const bool samp = unit >= 1024;
        if (!samp) {
            const int gr0 = unit * 64, t0 = gr0 & 8191;
#pragma unroll
            for (int it = 0; it < 10; ++it) { const int cc = tid + 512 * it; const int r = cc >> 6, c16 = cc & 63; const int tt = t0 - 15 + r; const bool ok = cc < 79 * 64;
                const int rs = (tt >= 0 && ok) ? gr0 - 15 + r : gr0;
                u32x4 v = *((const u32x4*)(Z + (size_t)rs * 1024 + 416) + c16);
                if (tt < 0) v = z4;
                if (ok) *(LAS u32x4*)(U + r * UROW + c16 * 16) = v; }
        } else {
            const int sj = unit - 1024;
            for (int cc = tid; cc < 94 * 64; cc += NTHREADS) { const int r = cc >> 6, c16 = cc & 63; const int bb = r >= 47 ? 1 : 0, rr = r - 47 * bb; const int b = 2 * sj + bb;
                u32x4 v;
                if (rr < 15) { const f32x4* sp = (const f32x4*)(P.in[I_SPOOL] + ((size_t)b * 15 + rr) * 512) + 2 * c16; const f32x4 a = sp[0], c = sp[1];
                    v.x = pk2(a[0], a[1]); v.y = pk2(a[2], a[3]); v.z = pk2(c[0], c[1]); v.w = pk2(c[2], c[3]); }
                else v = *((const u32x4*)(Z + (size_t)(NTOK_P + b * 32 + rr - 15) * 1024 + 416) + c16);
                *(LAS u32x4*)(U + r * UROW + c16 * 16) = v; }
        }
        u32x2 cqw[8]; unsigned kvw[8]; unsigned k1[8], k2[8]; float2 csv[8];
#pragma unroll
        for (int ii = 0; ii < 8; ++ii) { const int gr_ = unit * 64 + wave * 8 + ii; const bf16* zr = Z + (size_t)gr_ * 1024;
            cqw[ii] = *((const u32x2*)zr + lane); kvw[ii] = *((const unsigned*)(zr + 256) + lane); k1[ii] = zr[384 + (lane & 15)]; k2[ii] = zr[400 + (lane & 15)];
            const int pos_ = samp ? 4096 + ((gr_ - NTOK_P) & 31) : (gr_ & 8191); csv[ii] = *((const float2*)tab + (size_t)pos_ * 16 + (lane & 15)); }
        __syncthreads();
        float ac[8];
#pragma unroll
        for (int ii = 0; ii < 8; ++ii) {
            const int i = wave * 8 + ii; const int gr = unit * 64 + i;
            int b, t, pos, urow; size_t keyrow;
            if (!samp) { b = gr >> 13; t = gr & 8191; pos = t; keyrow = (size_t)gr; urow = 15 + i; }
            else { const int sr = gr - NTOK_P; b = sr >> 5; t = sr & 31; pos = 4096 + t; keyrow = (size_t)b * SKV + 4096 + t; urow = 47 * (i >> 5) + 15 + t; }
            bf16* KL = samp ? KLs : KLp;
            { const u32x2 w = cqw[ii]; const float a0 = bflo(w.x), a1 = bfhi(w.x), a2 = bflo(w.y), a3 = bfhi(w.y);
              const float rstd = __builtin_amdgcn_rsqf(wave_sum((a0 * a0 + a1 * a1) + (a2 * a2 + a3 * a3)) * (1.0f / 256.0f) + EPS);
              u32x2 o; o.x = pk2(a0 * rstd * gq[0], a1 * rstd * gq[1]); o.y = pk2(a2 * rstd * gq[2], a3 * rstd * gq[3]);
              *((u32x2*)(CQ + (size_t)gr * 256) + lane) = o; }
            { const unsigned w = kvw[ii]; const float a0 = bflo(w), a1 = bfhi(w);
              const float rstd = __builtin_amdgcn_rsqf(wave_sum(a0 * a0 + a1 * a1) * (1.0f / 128.0f) + EPS);
              const float v0 = a0 * rstd * gkv.x, v1 = a1 * rstd * gkv.y;
              float* okv = samp ? out + O_KVS + (size_t)(gr - NTOK_P) * 128 : out + O_KVP + (size_t)gr * 128;
              *((float2*)okv + lane) = make_float2(v0, v1);
              const unsigned pw = pk2(v0, v1);
              *((unsigned*)(KL + keyrow * 160) + ((((lane >> 2) ^ ((t >> 2) & 3)) << 2) + (lane & 3))) = pw;
            }
            if (lane < 16) {
                const float x1 = bflo(k1[ii]), x2 = bflo(k2[ii]);
                const float2 cs = csv[ii];
                const float o1 = x1 * cs.x - x2 * cs.y, o2 = x2 * cs.x + x1 * cs.y;
                float* okr = samp ? out + O_KRS + (size_t)(gr - NTOK_P) * 32 : out + O_KRP + (size_t)gr * 32;
                okr[lane] = o1; okr[16 + lane] = o2;
                *((unsigned*)(KL + keyrow * 160 + 128) + ((((lane >> 2) ^ ((t >> 2) & 3)) << 2) + (lane & 3))) = pk2(o1, o2);
            }
            { const LAS unsigned char* up = U + urow * UROW + lane * 16;
              const u32x4 uw = *(const LAS u32x4*)up;
              const float ut[8] = {bflo(uw.x), bfhi(uw.x), bflo(uw.y), bfhi(uw.y), bflo(uw.z), bfhi(uw.z), bflo(uw.w), bfhi(uw.w)};
              if (ii == 0) {
#pragma unroll
                  for (int e = 0; e < 8; ++e) ac[e] = ut[e];
#pragma unroll
                  for (int j = 1; j < 16; ++j) {
                      const u32x4 q = *(const LAS u32x4*)(up - j * UROW);
                      const float m = j < wwin ? 1.0f : 0.0f;
                      ac[0] += m * bflo(q.x); ac[1] += m * bfhi(q.x); ac[2] += m * bflo(q.y); ac[3] += m * bfhi(q.y); ac[4] += m * bflo(q.z); ac[5] += m * bfhi(q.z); ac[6] += m * bflo(q.w); ac[7] += m * bfhi(q.w);
                  }
              } else {
                  const u32x4 q = *(const LAS u32x4*)(up - wwin * UROW);
                  ac[0] += ut[0] - bflo(q.x); ac[1] += ut[1] - bfhi(q.x); ac[2] += ut[2] - bflo(q.y); ac[3] += ut[3] - bfhi(q.y); ac[4] += ut[4] - bflo(q.z); ac[5] += ut[5] - bfhi(q.z); ac[6] += ut[6] - bflo(q.w); ac[7] += ut[7] - bfhi(q.w);
              }
              const int cnt = samp ? wwin : (t + 1 < wwin ? t + 1 : wwin);
              const float ic = 1.0f / (float)cnt;
              u32x4 o; o.x = pk2(ac[0] * ic - ut[0], ac[1] * ic - ut[1]); o.y = pk2(ac[2] * ic - ut[2], ac[3] * ic - ut[3]); o.z = pk2(ac[4] * ic - ut[4], ac[5] * ic - ut[5]); o.w = pk2(ac[6] * ic - ut[6], ac[7] * ic - ut[7]);
              *((u32x4*)(POOLED + (size_t)gr * 512) + lane) = o;
              const int e0 = samp ? t - 17 : t - 8177;
              if (e0 >= 0) { float* op = out + (samp ? O_POOLS : O_POOLP) + ((size_t)b * 15 + e0) * 512; f32x4* o4 = (f32x4*)op + 2 * lane;
                  o4[0] = (f32x4){ut[0], ut[1], ut[2], ut[3]}; o4[1] = (f32x4){ut[4], ut[5], ut[6], ut[7]}; }
            }
        }
        if (samp) {
            const int sj = unit - 1024;
            for (int bb = 0; bb < 2; ++bb) { u32x4* padp = (u32x4*)(KLs + ((size_t)(2 * sj + bb) * SKV + 4128) * 160);
                for (int cc = tid; cc < 640; cc += NTHREADS) padp[cc] = z4; }
        }
        __syncthreads();
    }
}

namespace att {
constexpr int KROW = 320, KT_BYTES = 64 * KROW;
constexpr int KROW_UNUSED = 0;
constexpr float THR = 4.0f;
static_assert(5 * KT_BYTES <= 131072, "attention ring");
}
__device__ __forceinline__ float max3f(float a, float b, float c) { float r; asm("v_max3_f32 %0, %1, %2, %3" : "=v"(r) : "v"(a), "v"(b), "v"(c)); return r; }
__device__ __forceinline__ float max2f(float a, float b) { float r; asm("v_max_f32_e32 %0, %1, %2" : "=v"(r) : "v"(a), "v"(b)); return r; }
#define ATT_SB() __builtin_amdgcn_sched_barrier(0)
#define ATT_DMA(gsrc, ldsdst) __builtin_amdgcn_global_load_lds((const unsigned*)(gsrc), (LAS unsigned*)(ldsdst), 16, 0, 0)
#define ATT_WAITBAR(n) asm volatile("s_waitcnt vmcnt(" #n ") lgkmcnt(0)\n\ts_barrier" ::: "memory")

template <bool QK, bool PV>
__device__ __forceinline__ void att_step(f32x16& C0, f32x16& C1, f32x16& negm, const u32x4 (&pw)[2][2], u32x4 (&pn)[2][2], f32x16 (&o)[4], float& mhat, float& lrun, const bf16x8 (&qf)[10],
                                         const LAS unsigned char* kp, const LAS unsigned char* vp, bool maskC1, int ke, int ko, int vd) {
    using namespace att;
    constexpr int D = 4;
    if (QK) {
        __builtin_amdgcn_s_setprio(1);
        bf16x8 fr[D];
#pragma unroll
        for (int i = 0; i < D; ++i) fr[i] = *(const LAS bf16x8*)(kp + (i & 1) * 32 * KROW + ((i >> 1) >> 1) * 64 + (((i >> 1) & 1) ? ko : ke));
#pragma unroll
        for (int i = 0; i < 20; ++i) {
            const int ks = i >> 1;
            const bf16x8 a = fr[i % D];
            if (i & 1) { if (ks == 0) { const f32x16 z = {0.f, 0.f, 0.f, 0.f, 0.f, 0.f, 0.f, 0.f, 0.f, 0.f, 0.f, 0.f, 0.f, 0.f, 0.f, 0.f}; C1 = __builtin_amdgcn_mfma_f32_32x32x16_bf16(a, qf[0], PV ? negm : z, 0, 0, 0); }
                         else C1 = __builtin_amdgcn_mfma_f32_32x32x16_bf16(a, qf[ks], C1, 0, 0, 0); }
            else       { if (ks == 0) { const f32x16 z = {0.f, 0.f, 0.f, 0.f, 0.f, 0.f, 0.f, 0.f, 0.f, 0.f, 0.f, 0.f, 0.f, 0.f, 0.f, 0.f}; C0 = __builtin_amdgcn_mfma_f32_32x32x16_bf16(a, qf[0], PV ? negm : z, 0, 0, 0); }
                         else C0 = __builtin_amdgcn_mfma_f32_32x32x16_bf16(a, qf[ks], C0, 0, 0, 0); }
            if (i + D < 20) { const int j = i + D; fr[i % D] = *(const LAS bf16x8*)(kp + (j & 1) * 32 * KROW + ((j >> 1) >> 1) * 64 + (((j >> 1) & 1) ? ko : ke)); }
#ifdef PROBE_LDS2
            { }
#endif
            ATT_SB();
        }
        __builtin_amdgcn_s_setprio(0);
    }
#define ATT_VFRAG(i_) ({ const LAS unsigned char* p_ = vp + (32 * (((i_) >> 2) >> 1) + 16 * (((i_) >> 2) & 1)) * KROW + ((i_) & 3) * 64; \
        const s16x4 lo_ = __builtin_bit_cast(s16x4, __builtin_amdgcn_ds_read_tr16_b64_v4i16((LAS v4i16_t*)p_)); const s16x4 hi_ = __builtin_bit_cast(s16x4, __builtin_amdgcn_ds_read_tr16_b64_v4i16((LAS v4i16_t*)(p_ + vd))); \
        (bf16x8){lo_[0], lo_[1], lo_[2], lo_[3], hi_[0], hi_[1], hi_[2], hi_[3]}; })
    bf16x8 vr[D];
    if (PV) {
#pragma unroll
        for (int i = 0; i < D; ++i) vr[i] = ATT_VFRAG(i);
    }
    bool resc = false; float f = 1.f;
    if (QK) {
        asm volatile("s_nop 15\n\ts_nop 7" : "+v"(C0), "+v"(C1));
        if (maskC1) { asm volatile("" ::: "memory");
#pragma unroll
            for (int r = 0; r < 16; ++r) C1[r] = -1e30f; }
        float a = max3f(C0[0], C0[1], C0[2]), b = max3f(C0[3], C0[4], C0[5]), c4 = max3f(C1[0], C1[1], C1[2]), d4 = max3f(C1[3], C1[4], C1[5]);
        a = max3f(a, C0[6], C0[7]); b = max3f(b, C0[8], C0[9]); c4 = max3f(c4, C1[6], C1[7]); d4 = max3f(d4, C1[8], C1[9]);
        a = max3f(a, C0[10], C0[11]); b = max3f(b, C0[12], C0[13]); c4 = max3f(c4, C1[10], C1[11]); d4 = max3f(d4, C1[12], C1[13]);
        a = max3f(a, C0[14], C0[15]); c4 = max3f(c4, C1[14], C1[15]);
        float rm = max2f(max2f(a, b), max2f(c4, d4)); { auto rr = __builtin_amdgcn_permlane32_swap(__float_as_uint(rm), __float_as_uint(rm), false, false); rm = max2f(__uint_as_float(rr[0]), __uint_as_float(rr[1])); }
        if (!PV) { mhat = rm; }
        else if (__any(rm > THR)) {
            const float dl = max2f(rm, 0.f); f = __builtin_amdgcn_exp2f(-dl); mhat += dl; resc = true;
#pragma unroll
            for (int r = 0; r < 16; ++r) { C0[r] -= dl; C1[r] -= dl; negm[r] = -mhat; } }
    }
    ATT_SB();
    if (QK) asm volatile("s_waitcnt lgkmcnt(0)\n\ts_barrier" ::: "memory");
    float mh = mhat; float sacc = 0.f;
    if (PV) {
#pragma unroll
        for (int i = 0; i < 16; ++i) {
            const int db = i & 3, combo = i >> 2, kk = combo >> 1, s2 = combo & 1;
            o[db] = __builtin_amdgcn_mfma_f32_32x32x16_bf16(vr[i % D], __builtin_bit_cast(bf16x8, pw[kk][s2]), o[db], 0, 0, 0);
            if (i + D < 16) { vr[i % D] = ATT_VFRAG(i + D); }
#ifdef PROBE_LDS2
            { const bf16x8 dmy = ATT_VFRAG(i); asm volatile("" :: "v"(dmy)); }
#endif
            if (QK) { f32x16& X = (i < 8) ? C0 : C1; const int e = i & 7; const float p0 = __builtin_amdgcn_exp2f(X[2 * e]), p1 = __builtin_amdgcn_exp2f(X[2 * e + 1]);
                X[2 * e] = p0; X[2 * e + 1] = p1; sacc += p0 + p1; unsigned pkw = pk2v(p0, p1);
                asm volatile("" : "+v"(X), "+v"(sacc), "+v"(pkw));
                pn[i >> 3][e >> 2][e & 3] = pkw; }
            ATT_SB();
        }
    } else if (QK) {
#pragma unroll
        for (int i = 0; i < 16; ++i) { const f32x16& X = (i < 8) ? C0 : C1; const int e = i & 7; const float p0 = __builtin_amdgcn_exp2f(X[2 * e] - mh), p1 = __builtin_amdgcn_exp2f(X[2 * e + 1] - mh);
            sacc += p0 + p1; pn[i >> 3][e >> 2][e & 3] = pk2v(p0, p1); }
#pragma unroll
        for (int r = 0; r < 16; ++r) negm[r] = -mh;
    }
    if (QK) lrun = lrun * f + sacc;
    if (resc) {
#pragma unroll
        for (int db = 0; db < 4; ++db)
#pragma unroll
            for (int r = 0; r < 16; ++r) o[db][r] *= f;
    }
}

__device__ __forceinline__ void attn_phase(const Params& P, LAS unsigned char* lds, int cw = 0) {
    using namespace att;
    int tid_l = threadIdx.x; asm volatile("" : "+v"(tid_l)); const int tid = tid_l, lane = tid & 63, w = __builtin_amdgcn_readfirstlane(tid >> 6), q = lane & 31, h = lane >> 5;
    unsigned char* ws = P.ws;
    const bf16* QL = (const bf16*)(ws + WS_QL); const bf16* KLp = (const bf16*)(ws + WS_KLP); const bf16* KLs = (const bf16*)(ws + WS_KLS);
    bf16* OAo = (bf16*)(ws + WS_B);
    const bool xq = (gridDim.x & 7) == 0;
    const int queue = xq ? (int)(blockIdx.x & 7) : 0;
    unsigned* counter = (unsigned*)(ws + WS_CTL) + cw * 16 + queue;
    const unsigned nunits = xq ? 257u : 2056u;
    LAS unsigned* bcast = (LAS unsigned*)(lds + 131072);
    const LAS unsigned char* kread = lds + q * KROW;
    const int kg = (q >> 2) & 3, ke = ((h) ^ kg) * 16, ko = ((2 + h) ^ kg) * 16;
    const int tq = (lane & 15) >> 2, tp = lane & 3, tb = (lane >> 4) & 1, tc = 2 * tb + (tp >> 1);
    const LAS unsigned char* vread = lds + (4 * h + tq) * KROW + ((tc ^ h) << 4) + 8 * (tp & 1);
    const int vd = 8 * KROW + (((tc ^ (h ^ 2)) - (tc ^ h)) << 4);
    const int kc = w < 4 ? 3 : 2;
    for (;;) {
        if (tid == 0) bcast[0] = atomicAdd(counter, 1u);
        __syncthreads();
        const unsigned u = __builtin_amdgcn_readfirstlane(bcast[0]);
        if (u >= nunits) break;
        int row0, nt, b; bool samp;
        if (xq) { b = queue; if (u == 0u) { samp = true; row0 = NTOK_P + 32 * b; nt = 65; } else { const int p = (int)u - 1, c = 127 - (p >> 1); samp = false; row0 = b * 8192 + 64 * c + 32 * (p & 1); nt = c + 1; } }
        else if (u < 8u) { b = (int)u; samp = true; row0 = NTOK_P + 32 * b; nt = 65; }
        else { const int up = (int)u - 8, c = 127 - (up >> 4); b = (up & 15) >> 1; samp = false; row0 = b * 8192 + 64 * c + 32 * (up & 1); nt = c + 1; }
        const char* gKu = (const char*)(samp ? KLs + (size_t)b * SKV * 160 : KLp + (size_t)b * 8192 * 160);
        const unsigned loff = (unsigned)(lane * 16 + w * 1024);
        LAS unsigned char* dK = lds + w * 1024;
        { unsigned lo0 = loff; asm volatile("" : "+v"(lo0));
          for (int j = 0; j < kc; ++j) ATT_DMA(gKu + (size_t)(j * 8192) + lo0, dK + j * 8192);
          if (nt > 1) for (int j = 0; j < kc; ++j) ATT_DMA(gKu + (size_t)(KT_BYTES + j * 8192) + lo0, dK + KT_BYTES + j * 8192); }
        bf16x8 qf[10];
        { const bf16* qp = QL + (size_t)(row0 + q) * 1280 + w * 160 + 8 * h;
#pragma unroll
          for (int ks = 0; ks < 10; ++ks) qf[ks] = *(const bf16x8*)(qp + 16 * ks); }
        f32x16 o[4];
#pragma unroll
        for (int db = 0; db < 4; ++db)
#pragma unroll
            for (int r = 0; r < 16; ++r) o[db][r] = 0.f;
        float mhat = 0.f, lrun = 0.f;
        f32x16 C0, C1, negm; u32x4 pa[2][2], pb[2][2];
        ATT_WAITBAR(0);
        if (w >= 4) asm volatile("s_barrier" ::: "memory");
        int kA = 0, kP = 4, kD = 2;
#define ATT_STEP_ARGS(t) kread + kA * KT_BYTES, vread + kP * KT_BYTES, samp && ((t) == nt - 1), ke, ko, vd
#define ATT_STEP_DMA(t) do { if ((t) + 2 < nt) { unsigned lo_ = loff; asm volatile("" : "+v"(lo_)); const char* g_ = gKu + (size_t)((t) + 2) * KT_BYTES + lo_; LAS unsigned char* d_ = dK + kD * KT_BYTES; for (int j_ = 0; j_ < kc; ++j_) ATT_DMA(g_ + (size_t)(j_ * 8192), d_ + j_ * 8192); } } while (0)
#define ATT_STEP_END(t) do { ATT_WAITBAR(0); kP = kA; kA = (kA == 4) ? 0 : kA + 1; kD = (kD == 4) ? 0 : kD + 1; } while (0)
        ATT_STEP_DMA(0);
        att_step<true, false>(C0, C1, negm, pa, pb, o, mhat, lrun, qf, ATT_STEP_ARGS(0));
        ATT_STEP_END(0);
        for (int t = 1; t < nt; ++t) {
            ATT_STEP_DMA(t);
            att_step<true, true>(C0, C1, negm, pb, pa, o, mhat, lrun, qf, ATT_STEP_ARGS(t));
            ATT_STEP_END(t);
#pragma unroll
            for (int x = 0; x < 2; ++x)
#pragma unroll
                for (int y = 0; y < 2; ++y) pb[x][y] = pa[x][y];
        }
        if (w < 4) asm volatile("s_waitcnt lgkmcnt(0)\n\ts_barrier" ::: "memory");
        att_step<false, true>(C0, C1, negm, pb, pa, o, mhat, lrun, qf, kread, vread + kP * KT_BYTES, false, ke, ko, vd);
        lrun += __shfl_xor(lrun, 32);
        const float inv = 1.0f / lrun;
        f32x16 y0, y1;
#pragma unroll
        for (int r = 0; r < 16; ++r) { y0[r] = 0.f; y1[r] = 0.f; }
        { const bf16x8* wf = (const bf16x8*)(ws + WS_WUV) + (size_t)w * 16 * 64 + lane;
#pragma unroll
          for (int db = 0; db < 4; ++db)
#pragma unroll
            for (int s2 = 0; s2 < 2; ++s2) {
                u32x4 pk;
#pragma unroll
                for (int k2 = 0; k2 < 4; ++k2) pk[k2] = pk2v(o[db][8 * s2 + 2 * k2] * inv, o[db][8 * s2 + 2 * k2 + 1] * inv);
                const bf16x8 bfr = __builtin_bit_cast(bf16x8, pk);
                y0 = __builtin_amdgcn_mfma_f32_32x32x16_bf16(wf[((0 * 4 + db) * 2 + s2) * 64], bfr, y0, 0, 0, 0);
                y1 = __builtin_amdgcn_mfma_f32_32x32x16_bf16(wf[((1 * 4 + db) * 2 + s2) * 64], bfr, y1, 0, 0, 0);
            } }
        bf16* op = OAo + (size_t)(row0 + q) * 1024 + w * 64 + 4 * h;
        float ssq = 0.f;
#pragma unroll
        for (int rg = 0; rg < 4; ++rg) {
            u32x2 wv; wv.x = pk2v(y0[4 * rg], y0[4 * rg + 1]); wv.y = pk2v(y0[4 * rg + 2], y0[4 * rg + 3]); *(u32x2*)(op + 8 * rg) = wv;
            u32x2 wz; wz.x = pk2v(y1[4 * rg], y1[4 * rg + 1]); wz.y = pk2v(y1[4 * rg + 2], y1[4 * rg + 3]); *(u32x2*)(op + 32 + 8 * rg) = wz;
#pragma unroll
            for (int e2 = 0; e2 < 4; ++e2) ssq += y0[4 * rg + e2] * y0[4 * rg + e2] + y1[4 * rg + e2] * y1[4 * rg + e2]; }
        ssq += __shfl_xor(ssq, 32);
        LAS float* sA = (LAS float*)(lds + 131072 + 128);
        if (h == 0) sA[w * 32 + q] = ssq;
        __syncthreads();
        if (tid < 32) { float sa = 0.f;
#pragma unroll
            for (int ww = 0; ww < 8; ++ww) sa += sA[ww * 32 + tid];
            const f32x4* sp4 = (const f32x4*)((const float*)(ws + WS_SSP) + (size_t)(row0 + tid) * 8); const f32x4 p0 = sp4[0], p1 = sp4[1];
            const float spv = ((p0[0] + p0[1]) + (p0[2] + p0[3])) + ((p1[0] + p1[1]) + (p1[2] + p1[3]));
            const float ra = __builtin_amdgcn_rsqf(sa * (1.0f / 512.0f) + EPS), rpv = __builtin_amdgcn_rsqf(spv * (1.0f / 512.0f) + EPS);
            ((float*)(ws + WS_RP))[row0 + tid] = rpv; ((float*)(ws + WS_RATIO))[row0 + tid] = ra / rpv; }
    }
    __builtin_amdgcn_s_setprio(0);
#undef ATT_STEP_ARGS
#undef ATT_STEP_DMA
#undef ATT_STEP_END
}

__device__ __forceinline__ void final_norm_phase(const Params& P, int rbeg) {
    int tid_l = threadIdx.x; asm volatile("" : "+v"(tid_l)); const int tid = tid_l, lane = tid & 63, wave = tid >> 6;
    const int gw = blockIdx.x * 8 + wave, NGW = gridDim.x * 8;
    const f32x4* g4 = (const f32x4*)P.in[I_GF] + lane;
    f32x4 gg[4];
#pragma unroll
    for (int j = 0; j < 4; ++j) gg[j] = g4[64 * j];
    for (int row0 = rbeg + gw; row0 < NT; row0 += 2 * NGW) {
        f32x4 v[2][4]; f32x4* y[2];
#pragma unroll
        for (int k = 0; k < 2; ++k) { const int row = row0 + k * NGW < NT ? row0 + k * NGW : row0; y[k] = (f32x4*)(P.out + (size_t)row * 1024) + lane;
#pragma unroll
            for (int j = 0; j < 4; ++j) v[k][j] = y[k][64 * j]; }
#pragma unroll
        for (int k = 0; k < 2; ++k) {
            float sq = 0.f;
#pragma unroll
            for (int j = 0; j < 4; ++j) sq += (v[k][j][0] * v[k][j][0] + v[k][j][1] * v[k][j][1]) + (v[k][j][2] * v[k][j][2] + v[k][j][3] * v[k][j][3]);
            const float r = __builtin_amdgcn_rsqf(wave_sum(sq) * (1.0f / 1024.0f) + EPS);
            if (k == 0 || row0 + NGW < NT) {
#pragma unroll
                for (int j = 0; j < 4; ++j) y[k][64 * j] = v[k][j] * r * gg[j]; }
        }
    }
}

__device__ __forceinline__ int crow16(int r, int hi) { return (r & 3) + 8 * (r >> 2) + 4 * hi; }
template <class F>
__device__ __forceinline__ void mini_gemm(LAS unsigned char* lds, const bf16* A, const bf16* Bt, int K, int N, const F& epi) {
    int tid_l = threadIdx.x; asm volatile("" : "+v"(tid_l)); const int tid = tid_l, lane = tid & 63, w = __builtin_amdgcn_readfirstlane(tid >> 6), j = lane & 31, h = lane >> 5;
    const int ncb = N / 64, nblk = 8 * ncb, kw = K / 8;
    LAS float* part = (LAS float*)lds;
    for (int blk = blockIdx.x; blk < nblk; blk += gridDim.x) {
        const int rb = blk / ncb, cb = blk % ncb;
        const bf16* ap = A + (size_t)(32 * rb + j) * K + w * kw + 8 * h;
        const bf16* b0 = Bt + (size_t)(64 * cb + j) * K + w * kw + 8 * h; const bf16* b1 = b0 + (size_t)32 * K;
        f32x16 c0, c1;
#pragma unroll
        for (int r = 0; r < 16; ++r) { c0[r] = 0.f; c1[r] = 0.f; }
        for (int s2 = 0; s2 < kw; s2 += 64) {
            bf16x8 af[4], xf[4], yf[4];
#pragma unroll
            for (int u4 = 0; u4 < 4; ++u4) if (s2 + 16 * u4 < kw) { af[u4] = *(const bf16x8*)(ap + s2 + 16 * u4); xf[u4] = *(const bf16x8*)(b0 + s2 + 16 * u4); yf[u4] = *(const bf16x8*)(b1 + s2 + 16 * u4); }
#pragma unroll
            for (int u4 = 0; u4 < 4; ++u4) if (s2 + 16 * u4 < kw) { c0 = __builtin_amdgcn_mfma_f32_32x32x16_bf16(af[u4], xf[u4], c0, 0, 0, 0); c1 = __builtin_amdgcn_mfma_f32_32x32x16_bf16(af[u4], yf[u4], c1, 0, 0, 0); }
        }
#pragma unroll
        for (int r = 0; r < 16; ++r) { LAS float* pr = part + (w * 32 + crow16(r, h)) * 64 + j; pr[0] = c0[r]; pr[32] = c1[r]; }
        __syncthreads();
        const int r_out = tid >> 4, c4 = tid & 15;
        f32x4 alo = {0.f, 0.f, 0.f, 0.f}, ahi = {0.f, 0.f, 0.f, 0.f};
#pragma unroll
        for (int ww = 0; ww < 4; ++ww) { alo += *(const LAS f32x4*)(part + (ww * 32 + r_out) * 64 + 4 * c4); ahi += *(const LAS f32x4*)(part + ((ww + 4) * 32 + r_out) * 64 + 4 * c4); }
        epi(32 * rb + r_out, 64 * cb + 4 * c4, alo, ahi);
        __syncthreads();
    }
}
__device__ __forceinline__ void mini_gateup(LAS unsigned char* lds, const bf16* A, const bf16* WguT, const float* ss  , bf16* H  ) {
    int tid_l = threadIdx.x; asm volatile("" : "+v"(tid_l)); const int tid = tid_l, lane = tid & 63, w = __builtin_amdgcn_readfirstlane(tid >> 6), j = lane & 31, h = lane >> 5;
    constexpr int K = 1024, kw = K / 8, ncb = DFF / 32, nblk = 8 * ncb;
    LAS float* part = (LAS float*)lds;
    for (int blk = blockIdx.x; blk < nblk; blk += gridDim.x) {
        const int rb = blk / ncb, cb = blk % ncb, c0 = 32 * cb;
        const bf16* ap = A + (size_t)(32 * rb + j) * K + w * kw + 8 * h;
        const bf16* b0 = WguT + (size_t)(256 * (c0 >> 7) + (c0 & 127) + j) * K + w * kw + 8 * h; const bf16* b1 = b0 + (size_t)128 * K;
        f32x16 a0, a1;
#pragma unroll
        for (int r = 0; r < 16; ++r) { a0[r] = 0.f; a1[r] = 0.f; }
#pragma unroll
        for (int s2 = 0; s2 < kw; s2 += 16) { const bf16x8 a = *(const bf16x8*)(ap + s2), x = *(const bf16x8*)(b0 + s2), y = *(const bf16x8*)(b1 + s2);
            a0 = __builtin_amdgcn_mfma_f32_32x32x16_bf16(a, x, a0, 0, 0, 0); a1 = __builtin_amdgcn_mfma_f32_32x32x16_bf16(a, y, a1, 0, 0, 0); }
#pragma unroll
        for (int r = 0; r < 16; ++r) { LAS float* pr = part + (w * 32 + crow16(r, h)) * 64 + j; pr[0] = a0[r]; pr[32] = a1[r]; }
        __syncthreads();
        const int r_out = tid >> 4, c4 = tid & 15;
        if (c4 < 8) {
            f32x4 g = {0.f, 0.f, 0.f, 0.f}, u = {0.f, 0.f, 0.f, 0.f};
#pragma unroll
            for (int ww = 0; ww < 8; ++ww) { g += *(const LAS f32x4*)(part + (ww * 32 + r_out) * 64 + 4 * c4); u += *(const LAS f32x4*)(part + (ww * 32 + r_out) * 64 + 32 + 4 * c4); }
            const int row = 32 * rb + r_out;
            const f32x4* sp = (const f32x4*)(ss + (size_t)row * 16); const f32x4 sa = (sp[0] + sp[1]) + (sp[2] + sp[3]);
            const float r = __builtin_amdgcn_rsqf(((sa[0] + sa[1]) + (sa[2] + sa[3])) * (1.0f / 1024.0f) + EPS);
            float hv[4];
#pragma unroll
            for (int e = 0; e < 4; ++e) { const float gg = g[e] * r; hv[e] = gg * __builtin_amdgcn_rcpf(1.0f + __builtin_amdgcn_exp2f(-1.4426950408889634f * gg)) * (u[e] * r); }
            u32x2 wv; wv.x = pk2(hv[0], hv[1]); wv.y = pk2(hv[2], hv[3]);
            *(u32x2*)(H + (size_t)row * DFF + c0 + 4 * c4) = wv;
        }
        __syncthreads();
    }
}
struct MiniBf16 { bf16* O; int ldc; float* ss;
    __device__ __forceinline__ void operator()(int row, int col, f32x4 lo, f32x4 hi) const { const f32x4 v = lo + hi; u32x2 w; w.x = pk2(v[0], v[1]); w.y = pk2(v[2], v[3]); *(u32x2*)(O + (size_t)row * ldc + col) = w;
        if (ss) { float s = (v[0] * v[0] + v[1] * v[1]) + (v[2] * v[2] + v[3] * v[3]); s += __shfl_xor(s, 1); s += __shfl_xor(s, 2); s += __shfl_xor(s, 4); s += __shfl_xor(s, 8);
            if ((threadIdx.x & 15) == 0) ss[(size_t)row * 8 + (col >> 6)] = s; } } };
struct MiniQRope { bf16* O; const float* tab; float scale;
    __device__ __forceinline__ void operator()(int row, int col, f32x4 lo, f32x4 hi) const {
        f32x4 v = lo + hi; const int cm = col % 160;
        if (cm >= 128) { const int pos = 4096 + (row & 31), ip = (cm - 128) >> 1; const f32x4 t = *(const f32x4*)(tab + ((size_t)pos * 16 + ip) * 2);
            const float a0 = v[0], b0 = v[1], a1 = v[2], b1 = v[3]; v[0] = a0 * t[0] - b0 * t[1]; v[1] = b0 * t[0] + a0 * t[1]; v[2] = a1 * t[2] - b1 * t[3]; v[3] = b1 * t[2] + a1 * t[3]; }
        v = v * scale; u32x2 w; w.x = pk2(v[0], v[1]); w.y = pk2(v[2], v[3]); *(u32x2*)(O + (size_t)row * 1280 + col) = w; } };
template <bool WO> struct MiniRes { const float* xs; float* out; bf16* xb; float* ss; const float* ratio; const float* rp;
    __device__ __forceinline__ void operator()(int row, int col, f32x4 lo, f32x4 hi) const {
        const f32x4 acc = WO ? (lo * ratio[row] + hi) * rp[row] : lo + hi;
        float* dst = out + (size_t)row * 1024 + col; const f32x4 base = WO ? *(const f32x4*)(xs + (size_t)row * 1024 + col) : *(const f32x4*)dst;
        const f32x4 v = base + acc; *(f32x4*)dst = v;
        if (WO) { u32x2 w; w.x = pk2(v[0], v[1]); w.y = pk2(v[2], v[3]); *(u32x2*)(xb + (size_t)row * 1024 + col) = w;
            float s = (v[0] * v[0] + v[1] * v[1]) + (v[2] * v[2] + v[3] * v[3]); s += __shfl_xor(s, 1); s += __shfl_xor(s, 2); s += __shfl_xor(s, 4); s += __shfl_xor(s, 8);
            if ((threadIdx.x & 15) == 0) ss[(size_t)row * 16 + (col >> 6)] = s; } } };

#define XB_TMO      128
#define XB_XCNT(j)  (256  + 64 * (j))
#define XB_XSUB(j)  (1280 + 64 * (j))
#define XB_XGEN(j)  (2304 + 64 * (j))
#define XB_TOP      3328
#define XB_TOPGEN   3392
#define XCD_BAR_WORDS 3456
#define XB_SPIN_CAP (1u << 18)

__device__ __forceinline__ unsigned xb_ld(unsigned* p)              { return __hip_atomic_load(p, __ATOMIC_RELAXED, __HIP_MEMORY_SCOPE_AGENT); }
__device__ __forceinline__ unsigned xb_add(unsigned* p, unsigned v) { return __hip_atomic_fetch_add(p, v, __ATOMIC_RELAXED, __HIP_MEMORY_SCOPE_AGENT); }
__device__ __forceinline__ unsigned xb_xcc_id() { return (unsigned)__builtin_amdgcn_s_getreg((3 << 11) | 20) & 0xFu; }
#define XB_SPIN(cond, bar) do { unsigned _sp = 0; while (cond) { __builtin_amdgcn_s_sleep(1); \
    if ((++_sp & 255u) == 0u) { if (xb_ld(&(bar)[XB_TMO])) break; if (_sp > XB_SPIN_CAP) { atomicAdd(&(bar)[XB_TMO], 1u); break; } } } } while (0)

struct XcdBarrier {
    unsigned* bar; unsigned x;
    volatile LAS unsigned* st;
};

__device__ __forceinline__ XcdBarrier xcd_barrier_post(unsigned* bar, volatile LAS unsigned* st) {
    XcdBarrier b; b.bar = bar; b.x = xb_xcc_id(); b.st = st;
    if (threadIdx.x == 0) (void)xb_add(&bar[XB_XCNT(b.x)], 1u);
    return b;
}
__device__ __forceinline__ void xcd_barrier_complete(unsigned* bar, unsigned x, unsigned& nloc, unsigned& nx) {
    const unsigned G = gridDim.x * gridDim.y * gridDim.z;
    unsigned sum, cnt, mine, sp = 0u;
    for (;;) {
        sum = 0u; cnt = 0u; mine = 0u;
#pragma unroll
        for (unsigned j = 0; j < 16; ++j) { const unsigned c = xb_ld(&bar[XB_XCNT(j)]); sum += c; cnt += (c > 0u) ? 1u : 0u; mine = (j == x) ? c : mine; }
        if (sum == G) break;
        __builtin_amdgcn_s_sleep(1);
        if ((++sp & 255u) == 0u) { if (xb_ld(&bar[XB_TMO])) break; if (sp > XB_SPIN_CAP) { atomicAdd(&bar[XB_TMO], 1u); break; } }
    }
    nloc = mine > 0u ? mine : 1u; nx = cnt > 0u ? cnt : 1u;
}

__device__ __forceinline__ void xcd_barrier(const XcdBarrier& b) {
    asm volatile("s_waitcnt vmcnt(0)" ::: "memory");
    __syncthreads();
    if (threadIdx.x == 0) {
        unsigned* bar = b.bar;
        __builtin_amdgcn_s_waitcnt(0);
        unsigned nloc = b.st[0], nx = b.st[1];
        if (nloc == 0u) { xcd_barrier_complete(bar, b.x, nloc, nx); b.st[0] = nloc; b.st[1] = nx; }
        const unsigned old = xb_add(&bar[XB_XSUB(b.x)], 1u);
        const unsigned gen = old / nloc;
        if (old + 1u == (gen + 1u) * nloc) {
            __builtin_amdgcn_fence(__ATOMIC_RELEASE, "agent");
            asm volatile("s_waitcnt vmcnt(0)" ::: "memory");
            const unsigned og = xb_add(&bar[XB_TOP], 1u);
            const unsigned tg = og / nx;
            if (og + 1u == (tg + 1u) * nx) xb_add(&bar[XB_TOPGEN], 1u);
            else XB_SPIN(xb_ld(&bar[XB_TOPGEN]) == tg, bar);
            __builtin_amdgcn_fence(__ATOMIC_ACQUIRE, "agent");
            xb_add(&bar[XB_XGEN(b.x)], 1u);
            asm volatile("s_waitcnt vmcnt(0)" ::: "memory");
        } else {
            XB_SPIN(xb_ld(&bar[XB_XGEN(b.x)]) == gen, bar);
            __builtin_amdgcn_fence(__ATOMIC_ACQUIRE, "agent");
            asm volatile("s_waitcnt vmcnt(0)" ::: "memory");
        }
    }
    __syncthreads();
}

__global__ void __launch_bounds__(NTHREADS, 2) mk_fwd(Params P) {
    extern __shared__ __attribute__((aligned(16))) unsigned char lds_raw[];
    LAS unsigned char* lds = (LAS unsigned char*)lds_raw;
    cg::grid_group grid = cg::this_grid();
    { volatile LAS unsigned* st0 = (volatile LAS unsigned*)(lds + 131072 + 64); if (threadIdx.x < 2) st0[threadIdx.x] = 0u; __syncthreads(); }
    XcdBarrier xbar = xcd_barrier_post((unsigned*)(P.ws + WS_CTL) + 4096, (volatile LAS unsigned*)(lds + 131072 + 64));
    unsigned char* ws = P.ws;
    const int G = gridDim.x, c = blockIdx.x;
    using pg8::Gemm; using pg8::StaticOrder; using pg8::EpiBf16; using pg8::EpiQRope; using pg8::EpiRes; using pg8::EpiGateUp; using pg8::gemm_phase; using pg8::bf16_t;
    bf16_t* RA = (bf16_t*)(ws + WS_A); bf16_t* RB = (bf16_t*)(ws + WS_B);

#ifndef NO_P0
    p0_prologue(P, lds);
#ifdef PROBE_P0P2
    __syncthreads(); p0_prologue(P, lds);
#endif
#endif
    if (P.ws == nullptr) grid.sync();
    xcd_barrier(xbar);
    { MiniBf16 ME{RB + (size_t)NTOK_P * 1024, 1024, nullptr}; mini_gemm(lds, RA + (size_t)NTOK_P * 1024, (const bf16*)(ws + WS_WIN), 1024, 1024, ME); }
    { Gemm g{RA, (const bf16_t*)(ws + WS_WIN), NTOK_P, 1024, 1024}; StaticOrder S; S.init(NTOK_P, 1024, G, c); EpiBf16 E{RB, 1024, nullptr};
#ifndef NO_G1
      gemm_phase<EpiBf16, StaticOrder, true, true>(lds, g, S, E);
#endif
    }
    xcd_barrier(xbar);
#ifndef NO_P2
    p2_phase(P, lds);
#ifdef PROBE_P0P2
    __syncthreads(); p2_phase(P, lds);
#endif
#ifdef PROBE_SYNC
    for (int i_ = 0; i_ < 10; ++i_) xcd_barrier(xbar);
#endif
#endif
    xcd_barrier(xbar);
    { MiniQRope ME{(bf16*)(ws + WS_QL) + (size_t)NTOK_P * 1280, (const float*)(ws + WS_TAB), QSCALE}; mini_gemm(lds, (const bf16*)(ws + WS_CQ) + (size_t)NTOK_P * 256, (const bf16*)(ws + WS_WQ), 256, 1280, ME); }
    { MiniBf16 ME{RB + (size_t)NTOK_P * 1024 + 512, 1024, (float*)(ws + WS_SSP) + (size_t)NTOK_P * 8}; mini_gemm(lds, (const bf16*)(ws + WS_POOLED) + (size_t)NTOK_P * 512, (const bf16*)(ws + WS_WPOOL), 512, 512, ME); }
    { Gemm g{(const bf16_t*)(ws + WS_CQ), (const bf16_t*)(ws + WS_WQ), NTOK_P, 1280, 256}; StaticOrder S; S.init(NTOK_P, 1280, G, c); EpiQRope E{(bf16_t*)(ws + WS_QL), (const unsigned*)(ws + WS_TAB16), QSCALE};
#ifndef NO_G3
      gemm_phase<EpiQRope, StaticOrder, true, true>(lds, g, S, E);
#endif
    }
    { Gemm g{(const bf16_t*)(ws + WS_POOLED), (const bf16_t*)(ws + WS_WPOOL), NTOK_P, 512, 512}; StaticOrder S; S.init(NTOK_P, 512, G, (c + G - 8) % G); EpiBf16 E{RB + 512, 1024, (float*)(ws + WS_SSP)};
#ifndef NO_G3B
      gemm_phase<EpiBf16, StaticOrder, true, true>(lds, g, S, E);
#endif
    }
    xcd_barrier(xbar);
#ifndef NO_ATT
    attn_phase(P, lds);
#ifdef PROBE_ATT2
    __syncthreads(); attn_phase(P, lds, 1);
#endif
#endif
    xcd_barrier(xbar);
    { MiniRes<true> ME{P.in[I_XS], P.out + (size_t)NTOK_P * 1024, RA + (size_t)NTOK_P * 1024, (float*)(ws + WS_SS2) + (size_t)NTOK_P * 16, (const float*)(ws + WS_RATIO) + NTOK_P, (const float*)(ws + WS_RP) + NTOK_P}; mini_gemm(lds, RB + (size_t)NTOK_P * 1024, (const bf16*)(ws + WS_WO), 1024, 1024, ME); }
    { Gemm g{RB, (const bf16_t*)(ws + WS_WO), NTOK_P, 1024, 1024}; StaticOrder S; S.init(NTOK_P, 1024, G, c);
      EpiRes<true> E{P.in[I_XP], P.in[I_XS], P.out, RA, (float*)(ws + WS_SS2), (const float*)(ws + WS_RATIO), (const float*)(ws + WS_RP)};
#ifndef NO_G7
      gemm_phase<EpiRes<true>, StaticOrder, true, true>(lds, g, S, E);
#endif
    }
    xcd_barrier(xbar);
    mini_gateup(lds, RA + (size_t)NTOK_P * 1024, (const bf16*)(ws + WS_WGU), (const float*)(ws + WS_SS2) + (size_t)NTOK_P * 16, (bf16*)(ws + WS_H) + (size_t)NTOK_P * DFF);
    { Gemm g{RA, (const bf16_t*)(ws + WS_WGU), NTOK_P, 2 * DFF, 1024}; StaticOrder S; S.init(NTOK_P, 2 * DFF, G, c, P8_WGM); EpiGateUp E{(bf16_t*)(ws + WS_H), (const float*)(ws + WS_SS2)};
#ifndef NO_G8
      gemm_phase<EpiGateUp, StaticOrder, P8_ALIGN, P8_SP2>(lds, g, S, E);
#ifdef PROBE_G8X2
      __syncthreads(); gemm_phase<EpiGateUp, StaticOrder, true, true>(lds, g, S, E);
#endif
#endif
    }
    xcd_barrier(xbar);
    { MiniRes<false> ME{nullptr, P.out + (size_t)NTOK_P * 1024, nullptr, nullptr, nullptr, nullptr}; mini_gemm(lds, (const bf16*)(ws + WS_H) + (size_t)NTOK_P * DFF, (const bf16*)(ws + WS_WD), DFF, 1024, ME); }
    { Gemm g{(const bf16_t*)(ws + WS_H), (const bf16_t*)(ws + WS_WD), NTOK_P, 1024, DFF}; StaticOrder S; S.init(NTOK_P, 1024, G, c);
      if (G == 256) {
          pg8::EpiDownNorm E{P.out, P.in[I_GF], (float*)(ws + WS_XS), (unsigned*)(ws + WS_CTL) + 8192, (unsigned*)(ws + WS_CTL) + 8191, lds + 131072 + 2048};
          gemm_phase<pg8::EpiDownNorm, StaticOrder, true, true>(lds, g, S, E);
      } else {
          EpiRes<false> E{nullptr, nullptr, P.out, nullptr, nullptr, nullptr, nullptr};
          gemm_phase<EpiRes<false>, StaticOrder, true, true>(lds, g, S, E);
      }
    }
    xcd_barrier(xbar);
#ifndef NO_FN
    final_norm_phase(P, G == 256 ? NTOK_P : 0);
#endif
}

extern "C" void kernel_launch(void* const* d_in, const int* in_sizes, int n_in, void* d_out, int out_size, void* d_ws, size_t ws_size, hipStream_t stream) {
    static int grid = 0;
    if (grid == 0) {
        if (n_in != 22 || (size_t)out_size != O_END || ws_size < WS_END) { fprintf(stderr, "kernel_launch: unexpected problem: n_in %d out %d ws %zu (need %zu / %zu)\n", n_in, out_size, ws_size, (size_t)O_END, (size_t)WS_END); grid = -1; return; }
        int dev = 0, cus = 0, per_cu = 0;
        if (hipGetDevice(&dev) != hipSuccess || hipDeviceGetAttribute(&cus, hipDeviceAttributeMultiprocessorCount, dev) != hipSuccess) { fprintf(stderr, "kernel_launch: device query failed\n"); grid = -1; return; }
        if (hipFuncSetAttribute((const void*)mk_fwd, hipFuncAttributeMaxDynamicSharedMemorySize, LDS_BYTES) != hipSuccess) { fprintf(stderr, "kernel_launch: hipFuncSetAttribute failed\n"); grid = -1; return; }
        if (hipOccupancyMaxActiveBlocksPerMultiprocessor(&per_cu, (const void*)mk_fwd, NTHREADS, LDS_BYTES) != hipSuccess || per_cu < 1) { fprintf(stderr, "kernel_launch: occupancy query gave %d\n", per_cu); per_cu = 1; }
        (void)hipGetLastError();
        grid = cus * per_cu;
    }
    if (grid < 0) return;
    if (hipMemsetAsync((char*)d_ws + WS_CTL, 0, 131072, stream) != hipSuccess) { fprintf(stderr, "kernel_launch: hipMemsetAsync failed\n"); return; }
    Params p{};
    for (int i = 0; i < 22; ++i) p.in[i] = (const float*)d_in[i];
    p.out = (float*)d_out; p.ws = (unsigned char*)d_ws;
    void* args[] = {&p};
    hipError_t e = hipLaunchCooperativeKernel((const void*)mk_fwd, dim3(grid), dim3(NTHREADS), args, LDS_BYTES, stream);
    if (e != hipSuccess) fprintf(stderr, "kernel_launch: cooperative launch failed: %s (grid %d)\n", hipGetErrorString(e), grid);
}
```
